# Optimizing an MI355X kernel written in HIP

```python
import math
import jax, jax.numpy as jnp
from jax import lax
import numpy as np

D_MODEL = 1024
BATCH = 8
SEQ = 4096
DEPTH = 1

CHUNK = 64
LEFT_CHUNKS = 8
BAND_CHUNKS = LEFT_CHUNKS + 1
BAND = BAND_CHUNKS * CHUNK

N_HEADS = 8
HEAD_DIM = 64
ATTN_WIDTH = N_HEADS * HEAD_DIM
MAX_REL = 128
N_REL = CHUNK + MAX_REL
ATTN_SCALE = 1.0 / math.sqrt(HEAD_DIM)
NEG_INF = -1e30

SSM_WIDTH = 512
SSM_GROUP = 16
SSM_GROUPS = SSM_WIDTH // SSM_GROUP
SSM_STATE = 64
DT_MIN = 0.001
DT_MAX = 0.1

NORM_EPS = 1e-6
IN_COLS = 4 * ATTN_WIDTH + 2 * SSM_WIDTH + 2 * D_MODEL
SPLITS = list(np.cumsum([ATTN_WIDTH, ATTN_WIDTH, ATTN_WIDTH, ATTN_WIDTH, SSM_WIDTH, SSM_WIDTH, D_MODEL])[:])

kernel_name = "hybrid_band_attn_s5_gated_block"


def rms_norm(x, gain):
    xf = x.astype(jnp.float32)
    inv = lax.rsqrt(jnp.mean(xf * xf, axis=-1, keepdims=True) + NORM_EPS)
    return (xf * inv * gain.astype(jnp.float32)).astype(x.dtype)


def band_attention(q, k, v, rel_bias):
    b, l, h, dh = q.shape
    nc = l // CHUNK
    qc = q.reshape(b, nc, CHUNK, h, dh)
    kc = k.reshape(b, nc, CHUNK, h, dh)
    vc = v.reshape(b, nc, CHUNK, h, dh)
    pad = ((0, 0), (LEFT_CHUNKS, 0), (0, 0), (0, 0), (0, 0))
    kp = jnp.pad(kc, pad)
    vp = jnp.pad(vc, pad)
    k_band = jnp.stack([kp[:, j:j + nc] for j in range(BAND_CHUNKS)], axis=2).reshape(b, nc, BAND, h, dh)
    v_band = jnp.stack([vp[:, j:j + nc] for j in range(BAND_CHUNKS)], axis=2).reshape(b, nc, BAND, h, dh)
    scores = jnp.einsum("bnqhd,bnkhd->bnhqk", qc, k_band,
                        preferred_element_type=jnp.float32) * ATTN_SCALE
    qi = jnp.arange(CHUNK)[:, None] + LEFT_CHUNKS * CHUNK
    kp_idx = jnp.arange(BAND)[None, :]
    rel = jnp.clip(qi - kp_idx, -(CHUNK - 1), MAX_REL) + (CHUNK - 1)
    bias = rel_bias.astype(jnp.float32)[:, rel]
    key_chunk = jnp.arange(nc)[:, None] - LEFT_CHUNKS + (jnp.arange(BAND) // CHUNK)[None, :]
    valid = (key_chunk >= 0)[None, :, None, None, :]
    scores = jnp.where(valid, scores + bias[None, None], NEG_INF)
    probs = jax.nn.softmax(scores, axis=-1).astype(v.dtype)
    out = jnp.einsum("bnhqk,bnkhd->bnqhd", probs, v_band)
    return out.reshape(b, l, h * dh)


def _complex_linear_combine(e1, e2):
    a1r, a1i, b1r, b1i = e1
    a2r, a2i, b2r, b2i = e2
    ar = a2r * a1r - a2i * a1i
    ai = a2r * a1i + a2i * a1r
    br = a2r * b1r - a2i * b1i + b2r
    bi = a2r * b1i + a2i * b1r + b2i
    return ar, ai, br, bi


def s5_ssm(u, a_re, a_im, log_dt, b_re, b_im, c_re, c_im, d_skip):
    bsz, l, _ = u.shape
    f32 = jnp.float32
    uf = u.astype(f32).reshape(bsz, l, SSM_GROUPS, SSM_GROUP)
    lam_re = a_re.astype(f32)
    lam_im = a_im.astype(f32)
    dt = jnp.exp(log_dt.astype(f32))[:, None]
    mag = jnp.exp(lam_re * dt)
    ab_re = mag * jnp.cos(lam_im * dt)
    ab_im = mag * jnp.sin(lam_im * dt)
    n_re = ab_re - 1.0
    n_im = ab_im
    den = lam_re * lam_re + lam_im * lam_im
    f_re = ((n_re * lam_re + n_im * lam_im) / den)[..., None]
    f_im = ((n_im * lam_re - n_re * lam_im) / den)[..., None]
    br_ = b_re.astype(f32)
    bi_ = b_im.astype(f32)
    bb_re = f_re * br_ - f_im * bi_
    bb_im = f_re * bi_ + f_im * br_
    bu_re = jnp.einsum("blgc,gpc->blgp", uf, bb_re)
    bu_im = jnp.einsum("blgc,gpc->blgp", uf, bb_im)
    a_r = jnp.broadcast_to(ab_re, bu_re.shape)
    a_i = jnp.broadcast_to(ab_im, bu_im.shape)
    _, _, h_re, h_im = lax.associative_scan(_complex_linear_combine, (a_r, a_i, bu_re, bu_im), axis=1)
    y = (jnp.einsum("blgp,gcp->blgc", h_re, c_re.astype(f32))
         - jnp.einsum("blgp,gcp->blgc", h_im, c_im.astype(f32)))
    y = y.reshape(bsz, l, SSM_WIDTH) + d_skip.astype(f32) * uf.reshape(bsz, l, SSM_WIDTH)
    return y.astype(u.dtype)


def setup_inputs(seed: int = 0) -> dict:
    key = jax.random.key(seed)
    ks = jax.random.split(key, 20)
    f32 = jnp.float32
    x = jax.random.normal(ks[0], (BATCH, SEQ, D_MODEL), f32)
    norm_gain = 1.0 + 0.02 * jax.random.normal(ks[1], (DEPTH, D_MODEL), f32)
    w_in = jax.random.normal(ks[2], (DEPTH, D_MODEL, IN_COLS), f32) * D_MODEL ** -0.5
    rel_bias = 0.1 * jax.random.normal(ks[3], (DEPTH, N_HEADS, N_REL), f32)
    n_idx = jnp.arange(SSM_STATE, dtype=f32)[None, None, :]
    ssm_a_re = -0.5 + 0.01 * jax.random.normal(ks[4], (DEPTH, SSM_GROUPS, SSM_STATE), f32)
    ssm_a_im = math.pi * n_idx + 0.01 * jax.random.normal(ks[5], (DEPTH, SSM_GROUPS, SSM_STATE), f32)
    ssm_log_dt = jax.random.uniform(ks[6], (DEPTH, SSM_GROUPS), f32,
                                    minval=math.log(DT_MIN), maxval=math.log(DT_MAX))
    b_scale = (2.0 * SSM_GROUP) ** -0.5
    ssm_b_re = jax.random.normal(ks[7], (DEPTH, SSM_GROUPS, SSM_STATE, SSM_GROUP), f32) * b_scale
    ssm_b_im = jax.random.normal(ks[8], (DEPTH, SSM_GROUPS, SSM_STATE, SSM_GROUP), f32) * b_scale
    c_scale = (2.0 * SSM_STATE) ** -0.5
    ssm_c_re = jax.random.normal(ks[9], (DEPTH, SSM_GROUPS, SSM_GROUP, SSM_STATE), f32) * c_scale
    ssm_c_im = jax.random.normal(ks[10], (DEPTH, SSM_GROUPS, SSM_GROUP, SSM_STATE), f32) * c_scale
    ssm_d = jax.random.normal(ks[11], (DEPTH, SSM_WIDTH), f32)
    w_glu = jax.random.normal(ks[12], (DEPTH, SSM_WIDTH, 2 * SSM_WIDTH), f32) * SSM_WIDTH ** -0.5
    b_glu = 0.01 * jax.random.normal(ks[13], (DEPTH, 2 * SSM_WIDTH), f32)
    w_attn_out = jax.random.normal(ks[14], (DEPTH, ATTN_WIDTH, D_MODEL), f32) * ATTN_WIDTH ** -0.5
    w_ssm_out = jax.random.normal(ks[15], (DEPTH, SSM_WIDTH, D_MODEL), f32) * SSM_WIDTH ** -0.5
    gate_bias = 0.01 * jax.random.normal(ks[16], (DEPTH, 2 * D_MODEL), f32)
    w_out = jax.random.normal(ks[17], (DEPTH, D_MODEL, D_MODEL), f32) * D_MODEL ** -0.5
    final_gain = 1.0 + 0.02 * jax.random.normal(ks[18], (D_MODEL,), f32)
    return {"x": x, "norm_gain": norm_gain, "w_in": w_in, "rel_bias": rel_bias,
            "ssm_a_re": ssm_a_re, "ssm_a_im": ssm_a_im, "ssm_log_dt": ssm_log_dt,
            "ssm_b_re": ssm_b_re, "ssm_b_im": ssm_b_im, "ssm_c_re": ssm_c_re, "ssm_c_im": ssm_c_im,
            "ssm_d": ssm_d, "w_glu": w_glu, "b_glu": b_glu, "w_attn_out": w_attn_out,
            "w_ssm_out": w_ssm_out, "gate_bias": gate_bias, "w_out": w_out, "final_gain": final_gain}


def reference(x, norm_gain, w_in, rel_bias, ssm_a_re, ssm_a_im, ssm_log_dt, ssm_b_re, ssm_b_im,
              ssm_c_re, ssm_c_im, ssm_d, w_glu, b_glu, w_attn_out, w_ssm_out, gate_bias, w_out,
              final_gain):
    bsz, l, _ = x.shape
    for layer in range(DEPTH):
        h = rms_norm(x, norm_gain[layer])
        proj = h @ w_in[layer]
        q, k, v, z_a, u, z_s, g_a, g_s = jnp.split(proj, SPLITS, axis=-1)
        g_a = g_a + gate_bias[layer, :D_MODEL]
        g_s = g_s + gate_bias[layer, D_MODEL:]
        heads = lambda t: t.reshape(bsz, l, N_HEADS, HEAD_DIM)
        y_a = band_attention(heads(q), heads(k), heads(v), rel_bias[layer])
        y_a = (y_a * jax.nn.silu(z_a)) @ w_attn_out[layer]
        y_s = s5_ssm(u, ssm_a_re[layer], ssm_a_im[layer], ssm_log_dt[layer], ssm_b_re[layer],
                     ssm_b_im[layer], ssm_c_re[layer], ssm_c_im[layer], ssm_d[layer])
        y_s = jax.nn.gelu(y_s)
        glu_a, glu_b = jnp.split(y_s @ w_glu[layer] + b_glu[layer], 2, axis=-1)
        y_s = glu_a * jax.nn.sigmoid(glu_b)
        y_s = (y_s * jax.nn.silu(z_s)) @ w_ssm_out[layer]
        merged = jax.nn.sigmoid(g_a) * y_a + jax.nn.sigmoid(g_s) * y_s
        x = x + merged @ w_out[layer]
    return rms_norm(x, final_gain)
```

```cpp
#include <hip/hip_runtime.h>
#include <hip/hip_cooperative_groups.h>
#include <cstdio>
#include <cstdint>
namespace cg = cooperative_groups;

#define LAS __attribute__((address_space(3)))
typedef unsigned short bf16_t;
typedef short bf16x8 __attribute__((ext_vector_type(8)));
typedef short s16x4 __attribute__((ext_vector_type(4)));
typedef float f32x2 __attribute__((ext_vector_type(2)));
typedef float f32x4 __attribute__((ext_vector_type(4)));
typedef float f32x16 __attribute__((ext_vector_type(16)));
typedef unsigned u32x2 __attribute__((ext_vector_type(2)));
typedef unsigned u32x4 __attribute__((ext_vector_type(4)));
typedef __bf16 bf16x2_t __attribute__((ext_vector_type(2)));

constexpr int M_TOK = 32768, DM = 1024, NIN = 5120, SEQ = 4096, NBATCH = 8;
constexpr int C_Q = 0, C_K = 512, C_V = 1024, C_ZA = 1536, C_U = 2048, C_ZS = 2560, C_GA = 3072, C_GS = 4096;
constexpr float NORM_EPS = 1e-6f;
constexpr float LOG2E = 1.4426950408889634f;
constexpr size_t MiB = 1u << 20;
constexpr size_t WS_WIN = 0, WS_WGLU = 10 * MiB, WS_WAO = 11 * MiB, WS_WSO = 12 * MiB, WS_WOUT = 13 * MiB, WS_SSQ = 15 * MiB;
constexpr size_t WS_XN = 32 * MiB;
constexpr size_t WS_PROJ = 96 * MiB;
constexpr size_t WS_END = 416 * MiB;
constexpr int LDS_BYTES = 147456;
constexpr int NWAVES = 8;

__device__ __forceinline__ unsigned cvtpk(float lo, float hi) { f32x2 v = {lo, hi}; bf16x2_t b = __builtin_convertvector(v, bf16x2_t); return __builtin_bit_cast(unsigned, b); }
__device__ __forceinline__ float bflo(unsigned w) { return __uint_as_float(w << 16); }
__device__ __forceinline__ float bfhi(unsigned w) { return __uint_as_float(w & 0xffff0000u); }
__device__ __forceinline__ float sigm(float x) { return __builtin_amdgcn_rcpf(1.f + __builtin_amdgcn_exp2f(-LOG2E * x)); }
__device__ __forceinline__ float silu_f(float x) { return x * sigm(x); }
__device__ __forceinline__ float gelu_tanh_f(float x) { return x * sigm(1.5957691216057308f * (x + 0.044715f * x * x * x)); }
__device__ __forceinline__ float wave_sum(float v) {
#pragma unroll
    for (int o = 1; o < 64; o <<= 1) v += __shfl_xor(v, o);
    return v;
}

namespace pg8 {
constexpr int BM = 256, BK = 64, HALF = 128, HTB = HALF * BK * 2, STAGE_BYTES = 8 * HTB, NXCD = 8, WGM = 8;
__host__ __device__ __forceinline__ int lds_byte(int r, int c) { const int st = (r >> 4) * 2 + (c >> 5), rr = r & 15, cc = c & 31, ob = rr * 64 + cc * 2; return st * 1024 + (ob ^ (((ob >> 9) & 1) << 5)); }
__host__ __device__ __forceinline__ void stage_rc(int b, int& R, int& C) { const int st = b / 1024, sb = b % 1024, swz = sb ^ (((sb >> 9) & 1) << 5); R = (st >> 1) * 16 + swz / 64; C = (st & 1) * 32 + (swz % 64) / 2; }
__host__ __device__ __forceinline__ int perm32(int rho) { const int n = rho >> 4, i = rho & 15; return 8 * (i >> 2) + 4 * n + (i & 3); }

struct Unit { int pm, pn, z; };
struct Gemm { const bf16_t* A0; const bf16_t* A1; const bf16_t* B0; const bf16_t* B1; int lda, K; };

struct StaticOrder {
    int nM, nN, nwg, G, c, nz;
    __device__ void init(int M, int N, int G_, int c_, int nz_) { nM = M / BM; nN = N / BM; nwg = nM * nN; G = G_; c = c_; nz = nz_; }
    __device__ bool next(int i, Unit& u) const {
        const int ti = (nz == 2) ? (i >> 1) : i; u.z = (nz == 2) ? (i & 1) : 0;
        const long L = (long)ti * G + c; if (L >= nwg) return false;
        int wgid = (int)L; { const int q = nwg / NXCD, r = nwg % NXCD, xcd = wgid % NXCD, off = wgid / NXCD; wgid = (xcd < r ? xcd * (q + 1) : r * (q + 1) + (xcd - r) * q) + off; }
        const int nig = WGM * nN, gid = wgid / nig, fm = gid * WGM, gsz = (nM - fm) < WGM ? (nM - fm) : WGM;
        u.pm = fm + ((wgid % nig) % gsz); u.pn = (wgid % nig) / gsz; return true;
    }
};

template <class Epi>
__device__ __forceinline__ void gemm_phase(LAS unsigned char* lds, const Gemm g, const StaticOrder& S, const Epi& E) {
    int tid = threadIdx.x; asm volatile("" : "+v"(tid));
    const int wid = __builtin_amdgcn_readfirstlane(tid >> 6), lane = tid & 63, wr = wid >> 2, wc = wid & 3, fr = lane & 15, fq = lane >> 4;
    const int K = g.K, nt = K / BK, lda = g.lda;
    unsigned voffA[2], voffB[2];
#pragma unroll
    for (int i = 0; i < 2; ++i) { int R, C; stage_rc(tid * 16 + i * 8192, R, C); const int Rb = (R & ~31) + perm32(R & 31);
        voffA[i] = (unsigned)(R * lda + C) * 2u; voffB[i] = (unsigned)(Rb * K + C) * 2u; }
    const size_t kstep = (size_t)(BK * 2);
    const size_t hstepA = (size_t)HALF * lda * 2, tstepA = 2 * hstepA;
    const size_t hstepB = (size_t)HALF * K * 2, tstepB = 2 * hstepB;
    const unsigned ldsw = (unsigned)wid * 1024u;
    const int aoff = lds_byte(wr * 64 + fr, fq * 8), boff = lds_byte(wc * 32 + fr, fq * 8);
#define PG8_SA(b, h) (((b) * 2 + (h)) * HTB)
#define PG8_SB(b, h) ((4 + (b) * 2 + (h)) * HTB)
#define PG8_STAGE(bufoff, gbase, voff) do { _Pragma("unroll") for (int _i = 0; _i < 2; ++_i) \
        __builtin_amdgcn_global_load_lds((const unsigned*)((const char*)(gbase) + (voff)[_i]), (LAS unsigned*)(lds + (bufoff) + ldsw + _i * 8192), 16, 0, 0); } while (0)
#define PG8_LDA(dst, b, h) do { _Pragma("unroll") for (int m = 0; m < 4; ++m) _Pragma("unroll") for (int k = 0; k < 2; ++k) dst[m][k] = *(const LAS bf16x8*)(lds + PG8_SA(b, h) + aoff + m * 2048 + k * 1024); } while (0)
#define PG8_LDB(dst, b, h) do { _Pragma("unroll") for (int n = 0; n < 2; ++n) _Pragma("unroll") for (int k = 0; k < 2; ++k) dst[n][k] = *(const LAS bf16x8*)(lds + PG8_SB(b, h) + boff + n * 2048 + k * 1024); } while (0)
#define PG8_MMA(ai, bj, At, Bt) do { __builtin_amdgcn_s_setprio(1); _Pragma("unroll") for (int m = 0; m < 4; ++m) _Pragma("unroll") for (int n = 0; n < 2; ++n) _Pragma("unroll") for (int k = 0; k < 2; ++k) \
        acc[ai][bj][m][n] = __builtin_amdgcn_mfma_f32_16x16x32_bf16(Bt[n][k], At[m][k], acc[ai][bj][m][n], 0, 0, 0); __builtin_amdgcn_s_setprio(0); } while (0)
#define PG8_WAIT_V(n) asm volatile("s_waitcnt vmcnt(" #n ")" ::: "memory")
#define PG8_WAIT_L(n) asm volatile("s_waitcnt lgkmcnt(" #n ")" ::: "memory")
#define PG8_BAR __builtin_amdgcn_s_barrier()
#define PG8_SCHED __builtin_amdgcn_sched_barrier(0)
    Unit cur, nxt; int ui = 0;
    if (!S.next(0, cur)) return;
    f32x4 acc[2][2][4][2];
#pragma unroll
    for (int a = 0; a < 2; ++a)
#pragma unroll
        for (int b = 0; b < 2; ++b)
#pragma unroll
            for (int m = 0; m < 4; ++m)
#pragma unroll
                for (int n = 0; n < 2; ++n) acc[a][b][m][n] = (f32x4){0.f, 0.f, 0.f, 0.f};
    bf16x8 At[4][2], B0[2][2], B1[2][2];
    const char* cA = (const char*)(cur.z ? g.A1 : g.A0) + (size_t)cur.pm * tstepA; const char* cB = (const char*)(cur.z ? g.B1 : g.B0) + (size_t)cur.pn * tstepB;
    PG8_STAGE(PG8_SB(0, 0), cB, voffB); PG8_STAGE(PG8_SB(0, 1), cB + hstepB, voffB); PG8_STAGE(PG8_SA(0, 0), cA, voffA); PG8_STAGE(PG8_SA(0, 1), cA + hstepA, voffA);
    if (wr == 1) PG8_BAR;
    PG8_WAIT_V(2); PG8_BAR;
    PG8_STAGE(PG8_SB(1, 0), cB + kstep, voffB); PG8_STAGE(PG8_SA(1, 0), cA + kstep, voffA); PG8_STAGE(PG8_SB(1, 1), cB + hstepB + kstep, voffB);
    PG8_WAIT_V(6); PG8_BAR;
    for (;;) {
        const bool has_next = S.next(ui + 1, nxt);
        const char* nA = has_next ? (const char*)(nxt.z ? g.A1 : g.A0) + (size_t)nxt.pm * tstepA : cA; const char* nB = has_next ? (const char*)(nxt.z ? g.B1 : g.B0) + (size_t)nxt.pn * tstepB : cB;
        for (int t = 0; t < nt; t += 2) {
            const bool last = (t == nt - 2);
            const char* a1 = cA + (size_t)(t + 1) * kstep;
            const char* a2 = last ? nA : cA + (size_t)(t + 2) * kstep; const char* b2 = last ? nB : cB + (size_t)(t + 2) * kstep;
            const char* a3 = a2 + kstep; const char* b3 = b2 + kstep;
            PG8_LDB(B0, 0, 0); PG8_LDB(B1, 0, 1); PG8_SCHED; PG8_LDA(At, 0, 0); PG8_STAGE(PG8_SA(1, 1), a1 + hstepA, voffA);
            PG8_WAIT_V(8); PG8_WAIT_L(0); PG8_BAR; PG8_MMA(0, 0, At, B0); PG8_MMA(0, 1, At, B1); PG8_BAR; PG8_SCHED;
            PG8_LDA(At, 0, 1); PG8_STAGE(PG8_SB(0, 0), b2, voffB); PG8_STAGE(PG8_SB(0, 1), b2 + hstepB, voffB); PG8_STAGE(PG8_SA(0, 0), a2, voffA);
            PG8_WAIT_V(8); PG8_WAIT_L(0); PG8_BAR; PG8_MMA(1, 0, At, B0); PG8_MMA(1, 1, At, B1); PG8_BAR; PG8_SCHED;
            PG8_LDB(B0, 1, 0); PG8_LDB(B1, 1, 1); PG8_SCHED; PG8_LDA(At, 1, 0); PG8_STAGE(PG8_SA(0, 1), a2 + hstepA, voffA);
            PG8_WAIT_V(8); PG8_WAIT_L(0); PG8_BAR; PG8_MMA(0, 0, At, B0); PG8_MMA(0, 1, At, B1); PG8_BAR; PG8_SCHED;
            PG8_LDA(At, 1, 1); PG8_STAGE(PG8_SB(1, 0), b3, voffB); PG8_STAGE(PG8_SB(1, 1), b3 + hstepB, voffB); PG8_STAGE(PG8_SA(1, 0), a3, voffA);
            PG8_WAIT_V(8); PG8_WAIT_L(0); PG8_BAR; PG8_MMA(1, 0, At, B0); PG8_MMA(1, 1, At, B1); PG8_BAR; PG8_SCHED;
        }
        if (wr == 0) PG8_BAR;
        E(acc, cur, wr, wc, fr, fq);
        if (!has_next) break;
#pragma unroll
        for (int a = 0; a < 2; ++a)
#pragma unroll
            for (int b = 0; b < 2; ++b)
#pragma unroll
                for (int m = 0; m < 4; ++m)
#pragma unroll
                    for (int n = 0; n < 2; ++n) acc[a][b][m][n] = (f32x4){0.f, 0.f, 0.f, 0.f};
        cur = nxt; cA = nA; cB = nB; ++ui;
        if (wr == 1) PG8_BAR;
    }
    PG8_WAIT_V(0);
    PG8_BAR;
#undef PG8_SA
#undef PG8_SB
#undef PG8_STAGE
#undef PG8_LDA
#undef PG8_LDB
#undef PG8_MMA
#undef PG8_WAIT_V
#undef PG8_WAIT_L
#undef PG8_BAR
#undef PG8_SCHED
}

struct EpiProj {
    bf16_t* O; const float* gate_bias;
    __device__ __forceinline__ void operator()(const f32x4 (&acc)[2][2][4][2], const Unit& u, int wr, int wc, int fr, int fq) const {
        const int pn = u.pn;
        const int mode = (pn < 2) ? 1 : (pn < 6) ? 0 : (pn < 8) ? 2 : (pn < 10) ? 0 : (pn < 12) ? 2 : 3;
        const int row0 = u.pm * BM + wr * 64 + fr, col0 = pn * BM + wc * 32 + 8 * fq;
        f32x4 bv[2][2];
#pragma unroll
        for (int bj = 0; bj < 2; ++bj)
#pragma unroll
            for (int n = 0; n < 2; ++n) bv[bj][n] = (mode == 3) ? *(const f32x4*)(gate_bias + (col0 - C_GA) + bj * HALF + 4 * n) : (f32x4){0.f, 0.f, 0.f, 0.f};
#pragma unroll
        for (int ai = 0; ai < 2; ++ai)
#pragma unroll
            for (int m = 0; m < 4; ++m) { bf16_t* rowp = O + (size_t)(row0 + ai * HALF + m * 16) * NIN + col0;
#pragma unroll
                for (int bj = 0; bj < 2; ++bj) { f32x4 v0 = acc[ai][bj][m][0], v1 = acc[ai][bj][m][1];
                    if (mode == 1) { v0 = v0 * (0.125f * LOG2E); v1 = v1 * (0.125f * LOG2E); }
                    else if (mode == 2) {
#pragma unroll
                        for (int i = 0; i < 4; ++i) { v0[i] = silu_f(v0[i]); v1[i] = silu_f(v1[i]); } }
                    else if (mode == 3) { v0 = v0 + bv[bj][0]; v1 = v1 + bv[bj][1];
#pragma unroll
                        for (int i = 0; i < 4; ++i) { v0[i] = sigm(v0[i]); v1[i] = sigm(v1[i]); } }
                    u32x4 w; w.x = cvtpk(v0[0], v0[1]); w.y = cvtpk(v0[2], v0[3]); w.z = cvtpk(v1[0], v1[1]); w.w = cvtpk(v1[2], v1[3]);
                    *(u32x4*)(rowp + bj * HALF) = w; } }
    }
};
struct EpiGlu {
    bf16_t* P; const float* b_glu;
    __device__ __forceinline__ void operator()(const f32x4 (&acc)[2][2][4][2], const Unit& u, int wr, int wc, int fr, int fq) const {
        const int row0 = u.pm * BM + wr * 64 + fr, j0 = u.pn * HALF + wc * 32 + 8 * fq;
        f32x4 ba[2], bb[2];
#pragma unroll
        for (int n = 0; n < 2; ++n) { ba[n] = *(const f32x4*)(b_glu + j0 + 4 * n); bb[n] = *(const f32x4*)(b_glu + 512 + j0 + 4 * n); }
#pragma unroll
        for (int ai = 0; ai < 2; ++ai)
#pragma unroll
            for (int m = 0; m < 4; ++m) { bf16_t* zp = P + (size_t)(row0 + ai * HALF + m * 16) * NIN + C_ZS + j0;
                const u32x4 z = *(const u32x4*)zp; float r[8];
#pragma unroll
                for (int n = 0; n < 2; ++n) { const f32x4 a = acc[ai][0][m][n] + ba[n], b = acc[ai][1][m][n] + bb[n];
#pragma unroll
                    for (int i = 0; i < 4; ++i) r[4 * n + i] = a[i] * sigm(b[i]); }
                u32x4 w; w.x = cvtpk(r[0] * bflo(z.x), r[1] * bfhi(z.x)); w.y = cvtpk(r[2] * bflo(z.y), r[3] * bfhi(z.y));
                w.z = cvtpk(r[4] * bflo(z.z), r[5] * bfhi(z.z)); w.w = cvtpk(r[6] * bflo(z.w), r[7] * bfhi(z.w));
                *(u32x4*)zp = w; }
    }
};
struct EpiMerge {
    const bf16_t* P; float* tmp; bf16_t* MG;
    __device__ __forceinline__ void operator()(const f32x4 (&acc)[2][2][4][2], const Unit& u, int wr, int wc, int fr, int fq) const {
        const int row0 = u.pm * BM + wr * 64 + fr, col0 = u.pn * BM + wc * 32 + 8 * fq;
#pragma unroll
        for (int ai = 0; ai < 2; ++ai)
#pragma unroll
            for (int m = 0; m < 4; ++m) { const size_t row = (size_t)(row0 + ai * HALF + m * 16);
#pragma unroll
                for (int bj = 0; bj < 2; ++bj) { const int col = col0 + bj * HALF;
                    const u32x4 gt = *(const u32x4*)(P + row * NIN + (u.z ? C_GS : C_GA) + col);
                    f32x4 v0 = acc[ai][bj][m][0], v1 = acc[ai][bj][m][1];
                    v0[0] *= bflo(gt.x); v0[1] *= bfhi(gt.x); v0[2] *= bflo(gt.y); v0[3] *= bfhi(gt.y);
                    v1[0] *= bflo(gt.z); v1[1] *= bfhi(gt.z); v1[2] *= bflo(gt.w); v1[3] *= bfhi(gt.w);
                    float* tp = tmp + row * DM + col;
                    if (u.z == 0) { *(f32x4*)tp = v0; *(f32x4*)(tp + 4) = v1; }
                    else { v0 = v0 + *(const f32x4*)tp; v1 = v1 + *(const f32x4*)(tp + 4);
                        u32x4 w; w.x = cvtpk(v0[0], v0[1]); w.y = cvtpk(v0[2], v0[3]); w.z = cvtpk(v1[0], v1[1]); w.w = cvtpk(v1[2], v1[3]);
                        *(u32x4*)(MG + row * DM + col) = w; } } }
    }
};
struct EpiOut {
    const float* x; float* out; float* ssq;
    __device__ __forceinline__ void operator()(const f32x4 (&acc)[2][2][4][2], const Unit& u, int wr, int wc, int fr, int fq) const {
        const int row0 = u.pm * BM + wr * 64 + fr, col0 = u.pn * BM + wc * 32 + 8 * fq;
#pragma unroll
        for (int ai = 0; ai < 2; ++ai)
#pragma unroll
            for (int m = 0; m < 4; ++m) { const size_t row = (size_t)(row0 + ai * HALF + m * 16); float s = 0.f;
#pragma unroll
                for (int bj = 0; bj < 2; ++bj) { const size_t o = row * DM + col0 + bj * HALF;
                    const f32x4 v0 = acc[ai][bj][m][0] + *(const f32x4*)(x + o), v1 = acc[ai][bj][m][1] + *(const f32x4*)(x + o + 4);
                    *(f32x4*)(out + o) = v0; *(f32x4*)(out + o + 4) = v1;
                    s += (v0[0] * v0[0] + v0[1] * v0[1]) + (v0[2] * v0[2] + v0[3] * v0[3]) + (v1[0] * v1[0] + v1[1] * v1[1]) + (v1[2] * v1[2] + v1[3] * v1[3]); }
                s += __shfl_xor(s, 16); s += __shfl_xor(s, 32);
                if (fq == 0) ssq[row * 16 + u.pn * 4 + wc] = s; }
    }
};
}

__device__ __forceinline__ void p0_transpose_item(const float* W, int K, int N, bf16_t* WT, bool glu_map, LAS float* scr, int item, int lane) {
    const int nblk = N / 32, kb = item / nblk, nb = item % nblk, k0 = 64 * kb, n0 = 32 * nb;
    int r0 = n0;
    if (glu_map) { const int bj = n0 >> 9, rem = n0 & 511, pn = rem >> 7, w = rem & 127; r0 = 256 * pn + 128 * bj + w; }
#pragma unroll 8
    for (int i = 0; i < 32; ++i) { const int kk = 2 * i + (lane >> 5); scr[kk * 33 + (lane & 31)] = W[(size_t)(k0 + kk) * N + n0 + (lane & 31)]; }
    asm volatile("s_waitcnt lgkmcnt(0)" ::: "memory");
    const int c = lane & 7;
#pragma unroll
    for (int j = 0; j < 4; ++j) { const int n = (lane >> 3) + 8 * j; const LAS float* s = scr + (8 * c) * 33 + n;
        u32x4 o; o.x = cvtpk(s[0 * 33], s[1 * 33]); o.y = cvtpk(s[2 * 33], s[3 * 33]); o.z = cvtpk(s[4 * 33], s[5 * 33]); o.w = cvtpk(s[6 * 33], s[7 * 33]);
        *(u32x4*)(WT + (size_t)(r0 + n) * K + k0 + 8 * c) = o; }
    asm volatile("s_waitcnt lgkmcnt(0)" ::: "memory");
}

__device__ __forceinline__ void sincos_acc(float th, float& s, float& c) {
    const float k = rintf(th * 0.636619772f);
    float r = fmaf(-k, 1.57079637050628662109375f, th); r = fmaf(-k, -4.371139000186241e-08f, r);
    const int q = ((int)k) & 3; const float r2 = r * r;
    const float sp = r * (1.f + r2 * (-1.66666667e-1f + r2 * (8.33333333e-3f + r2 * (-1.98412698e-4f + r2 * 2.75573192e-6f))));
    const float cp = 1.f + r2 * (-0.5f + r2 * (4.16666667e-2f + r2 * (-1.38888889e-3f + r2 * (2.48015873e-5f + r2 * -2.75573192e-7f))));
    s = (q == 0) ? sp : (q == 1) ? cp : (q == 2) ? -sp : -cp;
    c = (q == 0) ? cp : (q == 1) ? -sp : (q == 2) ? -cp : sp;
}
struct SsmIn { const float *a_re, *a_im, *log_dt, *b_re, *b_im, *c_re, *c_im, *d; };
constexpr int SSM_HROW = 272;
constexpr int SSM_HTILE = 32 * SSM_HROW;
constexpr int SSM_E_OFF = NWAVES * SSM_HTILE;

__device__ __forceinline__ void ssm_unit(int b, int g, bf16_t* PROJ, const SsmIn& si, LAS unsigned char* lds, int wave, int lane) {
    asm volatile("" : "+v"(lane));
    const int n = lane & 31, hi = lane >> 5;
    const float dt = expf(si.log_dt[g]);
    float ar[2], ai[2], fre[2], fim[2];
#pragma unroll
    for (int s = 0; s < 2; ++s) { const int p = 32 * s + n;
        const float lre = si.a_re[g * 64 + p], lim = si.a_im[g * 64 + p];
        const float xx = lre * dt, th = lim * dt;
        const float em1 = xx * (1.f + xx * 0.5f * (1.f + xx * (1.f / 3.f) * (1.f + xx * 0.25f * (1.f + xx * 0.2f * (1.f + xx * (1.f / 6.f) * (1.f + xx * (1.f / 7.f)))))));
        const float mag = 1.f + em1;
        float sn, cs, sh, ch; sincos_acc(th, sn, cs); sincos_acc(0.5f * th, sh, ch);
        const float cm1 = -2.f * sh * sh;
        ar[s] = mag * cs; ai[s] = mag * sn;
        const float nre = em1 * cs + cm1, nim = mag * sn, den = lre * lre + lim * lim;
        fre[s] = (nre * lre + nim * lim) / den; fim[s] = (nim * lre - nre * lim) / den; }
    bf16x8 Bf[4];
#pragma unroll
    for (int s = 0; s < 2; ++s) { const int p = 32 * s + n; const float* br = si.b_re + ((size_t)(g * 64 + p)) * 16 + 8 * hi; const float* bi = si.b_im + ((size_t)(g * 64 + p)) * 16 + 8 * hi;
        float vr[8], vi[8];
#pragma unroll
        for (int j = 0; j < 8; ++j) { const float r_ = br[j], i_ = bi[j]; vr[j] = fre[s] * r_ - fim[s] * i_; vi[j] = fre[s] * i_ + fim[s] * r_; }
        u32x4 wr_, wi_; wr_.x = cvtpk(vr[0], vr[1]); wr_.y = cvtpk(vr[2], vr[3]); wr_.z = cvtpk(vr[4], vr[5]); wr_.w = cvtpk(vr[6], vr[7]);
        wi_.x = cvtpk(vi[0], vi[1]); wi_.y = cvtpk(vi[2], vi[3]); wi_.z = cvtpk(vi[4], vi[5]); wi_.w = cvtpk(vi[6], vi[7]);
        Bf[2 * s] = __builtin_bit_cast(bf16x8, wr_); Bf[2 * s + 1] = __builtin_bit_cast(bf16x8, wi_); }
    bf16x8 Cf[4];
    { const int c = lane & 15, q4 = lane >> 4;
#pragma unroll
        for (int ks = 0; ks < 4; ++ks) { float v[8];
#pragma unroll
            for (int j = 0; j < 8; ++j) { const int np = 8 * ks + 2 * q4 + (j >> 2), cb = j & 3; const int p = np + 32 * (cb >> 1);
                v[j] = (cb & 1) ? -si.c_im[((size_t)(g * 16 + c)) * 64 + p] : si.c_re[((size_t)(g * 16 + c)) * 64 + p]; }
            u32x4 w; w.x = cvtpk(v[0], v[1]); w.y = cvtpk(v[2], v[3]); w.z = cvtpk(v[4], v[5]); w.w = cvtpk(v[6], v[7]);
            Cf[ks] = __builtin_bit_cast(bf16x8, w); } }
    const int rho = n, ho = (rho >> 2) & 1, rr = (rho & 3) + 4 * (rho >> 3);
    bf16_t* ubase = PROJ + ((size_t)b * SEQ + 256 * (2 * wave + ho) + rr) * NIN + C_U + 16 * g + 8 * hi;
    LAS float* E = (LAS float*)(lds + SSM_E_OFF);
    const f32x16 z16 = {0.f, 0.f, 0.f, 0.f, 0.f, 0.f, 0.f, 0.f, 0.f, 0.f, 0.f, 0.f, 0.f, 0.f, 0.f, 0.f};
    float hre[2] = {0.f, 0.f}, him[2] = {0.f, 0.f};
    {
        bf16x8 uf = *(const bf16x8*)ubase;
        for (int blk = 0; blk < 16; ++blk) {
            bf16x8 ufn = uf; if (blk < 15) ufn = *(const bf16x8*)(ubase + (size_t)(16 * (blk + 1)) * NIN);
            f32x16 a4[4];
#pragma unroll
            for (int cb = 0; cb < 4; ++cb) a4[cb] = __builtin_amdgcn_mfma_f32_32x32x16_bf16(uf, Bf[cb], z16, 0, 0, 0);
#pragma unroll
            for (int r = 0; r < 16; ++r) {
#pragma unroll
                for (int s = 0; s < 2; ++s) { const float tr = fmaf(-ai[s], him[s], a4[2 * s][r]), ti = fmaf(ai[s], hre[s], a4[2 * s + 1][r]);
                    hre[s] = fmaf(ar[s], hre[s], tr); him[s] = fmaf(ar[s], him[s], ti); } }
            uf = ufn;
        }
        const int ss = 2 * wave + hi;
        E[ss * 128 + 0 * 32 + n] = hre[0]; E[ss * 128 + 1 * 32 + n] = him[0]; E[ss * 128 + 2 * 32 + n] = hre[1]; E[ss * 128 + 3 * 32 + n] = him[1];
    }
    __syncthreads();
    {
        float pr[2], pi[2];
#pragma unroll
        for (int s = 0; s < 2; ++s) { pr[s] = ar[s]; pi[s] = ai[s];
#pragma unroll
            for (int i = 0; i < 8; ++i) { const float t = pr[s] * pr[s] - pi[s] * pi[s]; pi[s] = 2.f * pr[s] * pi[s]; pr[s] = t; } }
        const int ss = 2 * wave + hi;
        hre[0] = hre[1] = him[0] = him[1] = 0.f;
        for (int k = 0; k < 15; ++k) { if (k < ss) {
#pragma unroll
                for (int s = 0; s < 2; ++s) { const float er = E[k * 128 + (2 * s) * 32 + n], ei = E[k * 128 + (2 * s + 1) * 32 + n];
                    const float t = pr[s] * hre[s] - pi[s] * him[s] + er; him[s] = pr[s] * him[s] + pi[s] * hre[s] + ei; hre[s] = t; } } }
    }
    {
        LAS unsigned char* Ht = lds + wave * SSM_HTILE;
        const int tk = lane & 15, q4 = lane >> 4;
        f32x4 dsk = *(const f32x4*)(si.d + 16 * g + 4 * q4);
        bf16x8 uf = *(const bf16x8*)ubase;
        for (int blk = 0; blk < 16; ++blk) {
            bf16x8 ufn = uf; if (blk < 15) ufn = *(const bf16x8*)(ubase + (size_t)(16 * (blk + 1)) * NIN);
            f32x16 a4[4];
#pragma unroll
            for (int cb = 0; cb < 4; ++cb) a4[cb] = __builtin_amdgcn_mfma_f32_32x32x16_bf16(uf, Bf[cb], z16, 0, 0, 0);
#pragma unroll
            for (int r = 0; r < 16; ++r) {
#pragma unroll
                for (int s = 0; s < 2; ++s) { const float tr = fmaf(-ai[s], him[s], a4[2 * s][r]), ti = fmaf(ai[s], hre[s], a4[2 * s + 1][r]);
                    hre[s] = fmaf(ar[s], hre[s], tr); him[s] = fmaf(ar[s], him[s], ti); }
                u32x2 w; w.x = cvtpk(hre[0], him[0]); w.y = cvtpk(hre[1], him[1]);
                *(LAS u32x2*)(Ht + (16 * hi + r) * SSM_HROW + 8 * n) = w; }
            asm volatile("s_waitcnt lgkmcnt(0)" ::: "memory");
#pragma unroll
            for (int tb = 0; tb < 2; ++tb) {
                f32x4 y = {0.f, 0.f, 0.f, 0.f};
#pragma unroll
                for (int ks = 0; ks < 4; ++ks) { const bf16x8 hb = *(const LAS bf16x8*)(Ht + (16 * tb + tk) * SSM_HROW + (32 * ks + 8 * q4) * 2);
                    y = __builtin_amdgcn_mfma_f32_16x16x32_bf16(Cf[ks], hb, y, 0, 0, 0); }
                bf16_t* up = PROJ + ((size_t)b * SEQ + 256 * (2 * wave + tb) + 16 * blk + tk) * NIN + C_U + 16 * g + 4 * q4;
                const u32x2 uu = *(const u32x2*)up;
                const float y0 = gelu_tanh_f(y[0] + dsk[0] * bflo(uu.x)), y1 = gelu_tanh_f(y[1] + dsk[1] * bfhi(uu.x));
                const float y2 = gelu_tanh_f(y[2] + dsk[2] * bflo(uu.y)), y3 = gelu_tanh_f(y[3] + dsk[3] * bfhi(uu.y));
                u32x2 w; w.x = cvtpk(y0, y1); w.y = cvtpk(y2, y3);
                *(u32x2*)up = w;
            }
            asm volatile("s_waitcnt lgkmcnt(0)" ::: "memory");
            uf = ufn;
        }
    }
    __syncthreads();
}

constexpr int ATT_WAVE_LDS = 2 * 4096 + 1024;
__device__ __forceinline__ void attn_build_table(const float* rel_bias, int h, LAS unsigned char* wl, int lane) {
    LAS float* T = (LAS float*)(wl + 8192);
    const float c0 = rel_bias[h * 192 + 191];
#pragma unroll
    for (int i = 0; i < 4; ++i) { const int idx = lane + 64 * i; T[idx] = (idx < 191) ? (rel_bias[h * 192 + idx] - c0) * LOG2E : 0.f; }
    asm volatile("s_waitcnt lgkmcnt(0)" ::: "memory");
}
__device__ __forceinline__ void attn_unit(int b, int nchunk, int h, bf16_t* PROJ, LAS unsigned char* wl, int lane) {
    asm volatile("" : "+v"(lane));
    const int q32 = lane & 31, hi = lane >> 5;
    const LAS float* T = (const LAS float*)(wl + 8192);
    const size_t tok0 = (size_t)b * SEQ + (size_t)nchunk * 64;
    bf16x8 qf[2][4];
#pragma unroll
    for (int qb = 0; qb < 2; ++qb)
#pragma unroll
        for (int ds = 0; ds < 4; ++ds) qf[qb][ds] = *(const bf16x8*)(PROJ + (tok0 + 32 * qb + q32) * NIN + C_Q + h * 64 + 16 * ds + 8 * hi);
    f32x16 o[2][2];
#pragma unroll
    for (int db = 0; db < 2; ++db)
#pragma unroll
        for (int qb = 0; qb < 2; ++qb)
#pragma unroll
            for (int r = 0; r < 16; ++r) o[db][qb][r] = 0.f;
    float mrun[2] = {-1e30f, -1e30f}, lrun[2] = {0.f, 0.f};
    const int j0 = (nchunk < 8) ? (8 - nchunk) : 0;
    const int t0 = 2 * j0;
#define KTOK(t) ((size_t)b * SEQ + (size_t)(nchunk - 8 + ((t) >> 1)) * 64 + 32 * ((t) & 1))
    bf16x8 kf[4]; u32x4 vch[4];
    { const size_t kt = KTOK(t0);
#pragma unroll
        for (int ds = 0; ds < 4; ++ds) kf[ds] = *(const bf16x8*)(PROJ + (kt + q32) * NIN + C_K + h * 64 + 16 * ds + 8 * hi);
#pragma unroll
        for (int i = 0; i < 4; ++i) { const int cc = lane + 64 * i, key = cc >> 3, c8 = cc & 7; vch[i] = *(const u32x4*)(PROJ + (kt + key) * NIN + C_V + h * 64 + 8 * c8); }
#pragma unroll
        for (int i = 0; i < 4; ++i) { const int cc = lane + 64 * i, key = cc >> 3, c8 = cc & 7; *(LAS u32x4*)(wl + (t0 & 1) * 4096 + (c8 >> 2) * 2048 + key * 64 + (c8 & 3) * 16) = vch[i]; }
    }
    const int gI = lane >> 4, li = lane & 15, qrow = li >> 2, pp = li & 3;
    const int vtr_off = (4 * hi + qrow) * 64 + (16 * (gI & 1) + 4 * pp) * 2;
    for (int t = t0; t < 18; ++t) {
        bf16x8 kfn[4];
        const bool more = (t + 1 < 18);
        if (more) { const size_t kt = KTOK(t + 1);
#pragma unroll
            for (int ds = 0; ds < 4; ++ds) kfn[ds] = *(const bf16x8*)(PROJ + (kt + q32) * NIN + C_K + h * 64 + 16 * ds + 8 * hi);
#pragma unroll
            for (int i = 0; i < 4; ++i) { const int cc = lane + 64 * i, key = cc >> 3, c8 = cc & 7; vch[i] = *(const u32x4*)(PROJ + (kt + key) * NIN + C_V + h * 64 + 8 * c8); }
        } else {
#pragma unroll
            for (int ds = 0; ds < 4; ++ds) kfn[ds] = kf[ds];
        }
        const int j = t >> 1, kb = t & 1;
        f32x16 s[2];
        if (j >= 6) {
#pragma unroll
            for (int qb = 0; qb < 2; ++qb) { const int base = 32 * qb + q32 - 32 * kb - 4 * hi + 64 * (8 - j) + 63;
#pragma unroll
                for (int r = 0; r < 16; ++r) s[qb][r] = T[base - ((r & 3) + 8 * (r >> 2))]; }
        } else {
#pragma unroll
            for (int qb = 0; qb < 2; ++qb)
#pragma unroll
                for (int r = 0; r < 16; ++r) s[qb][r] = 0.f;
        }
#pragma unroll
        for (int ds = 0; ds < 4; ++ds)
#pragma unroll
            for (int qb = 0; qb < 2; ++qb) s[qb] = __builtin_amdgcn_mfma_f32_32x32x16_bf16(kf[ds], qf[qb][ds], s[qb], 0, 0, 0);
        bf16x8 pf[2][2];
#pragma unroll
        for (int qb = 0; qb < 2; ++qb) {
            float mx = s[qb][0];
#pragma unroll
            for (int r = 1; r < 16; ++r) mx = fmaxf(mx, s[qb][r]);
            mx = fmaxf(mx, __shfl_xor(mx, 32));
            const float mnew = fmaxf(mrun[qb], mx);
            const float alpha = __builtin_amdgcn_exp2f(mrun[qb] - mnew);
            mrun[qb] = mnew;
            float ls = 0.f;
#pragma unroll
            for (int r = 0; r < 16; ++r) { const float p = __builtin_amdgcn_exp2f(s[qb][r] - mnew); s[qb][r] = p; ls += p; }
            lrun[qb] = lrun[qb] * alpha + ls;
#pragma unroll
            for (int db = 0; db < 2; ++db)
#pragma unroll
                for (int r = 0; r < 16; ++r) o[db][qb][r] *= alpha;
#pragma unroll
            for (int s2 = 0; s2 < 2; ++s2) { u32x4 w; w.x = cvtpk(s[qb][8 * s2 + 0], s[qb][8 * s2 + 1]); w.y = cvtpk(s[qb][8 * s2 + 2], s[qb][8 * s2 + 3]);
                w.z = cvtpk(s[qb][8 * s2 + 4], s[qb][8 * s2 + 5]); w.w = cvtpk(s[qb][8 * s2 + 6], s[qb][8 * s2 + 7]); pf[qb][s2] = __builtin_bit_cast(bf16x8, w); }
        }
        asm volatile("s_waitcnt lgkmcnt(0)" ::: "memory");
        { LAS unsigned char* vb = wl + (t & 1) * 4096 + vtr_off;
#pragma unroll
            for (int db = 0; db < 2; ++db)
#pragma unroll
                for (int s2 = 0; s2 < 2; ++s2) {
                    const s16x4 lo = __builtin_bit_cast(s16x4, __builtin_amdgcn_ds_read_tr16_b64_v4i16((LAS s16x4*)(vb + db * 2048 + (16 * s2) * 64)));
                    const s16x4 hh = __builtin_bit_cast(s16x4, __builtin_amdgcn_ds_read_tr16_b64_v4i16((LAS s16x4*)(vb + db * 2048 + (16 * s2 + 8) * 64)));
                    const bf16x8 vf = {lo[0], lo[1], lo[2], lo[3], hh[0], hh[1], hh[2], hh[3]};
#pragma unroll
                    for (int qb = 0; qb < 2; ++qb) o[db][qb] = __builtin_amdgcn_mfma_f32_32x32x16_bf16(vf, pf[qb][s2], o[db][qb], 0, 0, 0);
                } }
        asm volatile("s_waitcnt lgkmcnt(0)" ::: "memory");
        if (more) {
#pragma unroll
            for (int i = 0; i < 4; ++i) { const int cc = lane + 64 * i, key = cc >> 3, c8 = cc & 7; *(LAS u32x4*)(wl + ((t + 1) & 1) * 4096 + (c8 >> 2) * 2048 + key * 64 + (c8 & 3) * 16) = vch[i]; }
        }
#pragma unroll
        for (int ds = 0; ds < 4; ++ds) kf[ds] = kfn[ds];
    }
#undef KTOK
#pragma unroll
    for (int qb = 0; qb < 2; ++qb) {
        const float lt = lrun[qb] + __shfl_xor(lrun[qb], 32);
        const float inv = 1.0f / lt;
        bf16_t* rowp = PROJ + (tok0 + 32 * qb + q32) * NIN + h * 64;
#pragma unroll
        for (int db = 0; db < 2; ++db)
#pragma unroll
            for (int g4 = 0; g4 < 4; ++g4) { const int d0 = 32 * db + 8 * g4 + 4 * hi;
                const u32x2 za = *(const u32x2*)(rowp + C_ZA + d0);
                u32x2 w; w.x = cvtpk(o[db][qb][4 * g4 + 0] * inv * bflo(za.x), o[db][qb][4 * g4 + 1] * inv * bfhi(za.x));
                w.y = cvtpk(o[db][qb][4 * g4 + 2] * inv * bflo(za.y), o[db][qb][4 * g4 + 3] * inv * bfhi(za.y));
                *(u32x2*)(rowp + C_Q + d0) = w; }
    }
    asm volatile("s_waitcnt lgkmcnt(0)" ::: "memory");
}

struct Args {
    const float* in[19]; float* out; unsigned char* ws;
};

__global__ void __launch_bounds__(NWAVES * 64, 2) fwd_megakernel(Args a) {
    extern __shared__ __attribute__((aligned(16))) unsigned char lds_raw[];
    LAS unsigned char* lds = (LAS unsigned char*)lds_raw;
    cg::grid_group grid = cg::this_grid();
    const int tid = threadIdx.x, lane = tid & 63, wave = __builtin_amdgcn_readfirstlane(tid >> 6);
    const int G = gridDim.x, bx = blockIdx.x;
    const int vcu = (G % 8 == 0) ? (bx % 8) * (G / 8) + bx / 8 : bx;
    unsigned char* ws = a.ws;
    const float* x = a.in[0];
    bf16_t* WinT = (bf16_t*)(ws + WS_WIN); bf16_t* WgluT = (bf16_t*)(ws + WS_WGLU); bf16_t* WaoT = (bf16_t*)(ws + WS_WAO);
    bf16_t* WsoT = (bf16_t*)(ws + WS_WSO); bf16_t* WoutT = (bf16_t*)(ws + WS_WOUT);
    float* SSQ = (float*)(ws + WS_SSQ);
    bf16_t* XN = (bf16_t*)(ws + WS_XN);
    bf16_t* PROJ = (bf16_t*)(ws + WS_PROJ);

    {
        LAS float* scr = (LAS float*)(lds + wave * 16384);
        const int gw = bx * NWAVES + wave, NGW = G * NWAVES;
        constexpr int I_IN = (DM / 64) * (NIN / 32), I_GLU = (512 / 64) * (1024 / 32), I_AO = I_GLU, I_SO = I_GLU, I_OUT = (DM / 64) * (DM / 32);
        constexpr int NITEMS = I_IN + I_GLU + I_AO + I_SO + I_OUT;
        for (int it = gw; it < NITEMS; it += NGW) {
            int r = it;
            if (r < I_IN) { p0_transpose_item(a.in[2], DM, NIN, WinT, false, scr, r, lane); continue; } r -= I_IN;
            if (r < I_GLU) { p0_transpose_item(a.in[12], 512, 1024, WgluT, true, scr, r, lane); continue; } r -= I_GLU;
            if (r < I_AO) { p0_transpose_item(a.in[14], 512, 1024, WaoT, false, scr, r, lane); continue; } r -= I_AO;
            if (r < I_SO) { p0_transpose_item(a.in[15], 512, 1024, WsoT, false, scr, r, lane); continue; } r -= I_SO;
            p0_transpose_item(a.in[17], DM, DM, WoutT, false, scr, r, lane);
        }
        const float* gain = a.in[1];
        f32x4 gv[4];
#pragma unroll
        for (int j = 0; j < 4; ++j) gv[j] = *(const f32x4*)(gain + 4 * lane + 256 * j);
        for (int m = gw; m < M_TOK; m += NGW) {
            const f32x4* xr = (const f32x4*)(x + (size_t)m * DM) + lane;
            f32x4 v[4]; float s = 0.f;
#pragma unroll
            for (int j = 0; j < 4; ++j) { v[j] = xr[64 * j]; s += (v[j][0] * v[j][0] + v[j][1] * v[j][1]) + (v[j][2] * v[j][2] + v[j][3] * v[j][3]); }
            const float inv = 1.0f / sqrtf(wave_sum(s) * (1.f / DM) + NORM_EPS);
            u32x2* o8 = (u32x2*)(XN + (size_t)m * DM) + lane;
#pragma unroll
            for (int j = 0; j < 4; ++j) { u32x2 w; w.x = cvtpk(v[j][0] * inv * gv[j][0], v[j][1] * inv * gv[j][1]); w.y = cvtpk(v[j][2] * inv * gv[j][2], v[j][3] * inv * gv[j][3]); o8[64 * j] = w; }
        }
    }
    grid.sync();

    {
        pg8::Gemm g{XN, XN, WinT, WinT, DM, DM}; pg8::StaticOrder S; S.init(M_TOK, NIN, G, bx, 1);
        pg8::EpiProj E{PROJ, a.in[16]};
        pg8::gemm_phase<pg8::EpiProj>(lds, g, S, E);
    }
    grid.sync();

    {
        SsmIn si{a.in[4], a.in[5], a.in[6], a.in[7], a.in[8], a.in[9], a.in[10], a.in[11]};
        for (int sidx = vcu; sidx < NBATCH * 32; sidx += G) ssm_unit(sidx >> 5, sidx & 31, PROJ, si, lds, wave, lane);
        LAS unsigned char* wl = lds + wave * ATT_WAVE_LDS;
        attn_build_table(a.in[3], wave, wl, lane);
        const int NU = NBATCH * 64, per = (NU + G - 1) / G;
        for (int i = 0; i < per; ++i) { const int uidx = vcu * per + i; if (uidx < NU) attn_unit(uidx >> 6, uidx & 63, wave, PROJ, wl, lane); }
    }
    grid.sync();

    {
        pg8::Gemm g{PROJ + C_U, PROJ + C_U, WgluT, WgluT, NIN, 512}; pg8::StaticOrder S; S.init(M_TOK, 1024, G, bx, 1);
        pg8::EpiGlu E{PROJ, a.in[13]};
        pg8::gemm_phase<pg8::EpiGlu>(lds, g, S, E);
    }
    grid.sync();

    {
        pg8::Gemm g{PROJ + C_Q, PROJ + C_ZS, WaoT, WsoT, NIN, 512}; pg8::StaticOrder S; S.init(M_TOK, DM, G, bx, 2);
        pg8::EpiMerge E{PROJ, a.out, XN};
        pg8::gemm_phase<pg8::EpiMerge>(lds, g, S, E);
    }
    grid.sync();

    {
        pg8::Gemm g{XN, XN, WoutT, WoutT, DM, DM}; pg8::StaticOrder S; S.init(M_TOK, DM, G, bx, 1);
        pg8::EpiOut E{x, a.out, SSQ};
        pg8::gemm_phase<pg8::EpiOut>(lds, g, S, E);
    }
    grid.sync();

    {
        const int gw = bx * NWAVES + wave, NGW = G * NWAVES;
        const float* gain = a.in[18];
        f32x4 gv[4];
#pragma unroll
        for (int j = 0; j < 4; ++j) gv[j] = *(const f32x4*)(gain + 4 * lane + 256 * j);
        for (int m = gw; m < M_TOK; m += NGW) {
            const f32x4* sp = (const f32x4*)(SSQ + (size_t)m * 16);
            const f32x4 s0 = sp[0], s1 = sp[1], s2 = sp[2], s3 = sp[3];
            const float ss = ((s0[0] + s0[1]) + (s0[2] + s0[3])) + ((s1[0] + s1[1]) + (s1[2] + s1[3])) + ((s2[0] + s2[1]) + (s2[2] + s2[3])) + ((s3[0] + s3[1]) + (s3[2] + s3[3]));
            const float inv = 1.0f / sqrtf(ss * (1.f / DM) + NORM_EPS);
            f32x4* orow = (f32x4*)(a.out + (size_t)m * DM) + lane;
#pragma unroll
            for (int j = 0; j < 4; ++j) { f32x4 v = orow[64 * j]; v = v * inv * gv[j]; orow[64 * j] = v; }
        }
    }
}

extern "C" void kernel_launch(void* const* d_in, const int* in_sizes, int n_in, void* d_out, int out_size, void* d_ws, size_t ws_size, hipStream_t stream) {
    static int grid = 0;
    if (grid == 0) {
        if (n_in != 19 || in_sizes[0] != M_TOK * DM || out_size != M_TOK * DM || ws_size < WS_END) { fprintf(stderr, "kernel_launch: unexpected shapes (n_in %d, ws %zu)\n", n_in, ws_size); grid = -1; return; }
        int dev = 0, cus = 0, per_cu = 0;
        hipGetDevice(&dev);
        hipDeviceGetAttribute(&cus, hipDeviceAttributeMultiprocessorCount, dev);
        hipFuncSetAttribute((const void*)fwd_megakernel, hipFuncAttributeMaxDynamicSharedMemorySize, LDS_BYTES);
        hipOccupancyMaxActiveBlocksPerMultiprocessor(&per_cu, (const void*)fwd_megakernel, NWAVES * 64, LDS_BYTES);
        if (per_cu < 1) per_cu = 1;
        grid = cus * per_cu;
        (void)hipGetLastError();
    }
    if (grid < 0) return;
    Args a{};
    for (int i = 0; i < 19; ++i) a.in[i] = (const float*)d_in[i];
    a.out = (float*)d_out; a.ws = (unsigned char*)d_ws;
    void* args[] = {&a};
    hipError_t e = hipLaunchCooperativeKernel((const void*)fwd_megakernel, dim3(grid), dim3(NWAVES * 64), args, LDS_BYTES, stream);
    if (e != hipSuccess) fprintf(stderr, "cooperative launch failed: %s (grid %d)\n", hipGetErrorString(e), grid);
}
```

```cpp
#include <hip/hip_runtime.h>
#include <hip/hip_cooperative_groups.h>
#include <cstdio>
#include <cstdint>
namespace cg = cooperative_groups;

#define LAS __attribute__((address_space(3)))
typedef unsigned short bf16_t;
typedef short bf16x8 __attribute__((ext_vector_type(8)));
typedef short s16x4 __attribute__((ext_vector_type(4)));
typedef float f32x2 __attribute__((ext_vector_type(2)));
typedef float f32x4 __attribute__((ext_vector_type(4)));
typedef float f32x16 __attribute__((ext_vector_type(16)));
typedef unsigned u32x2 __attribute__((ext_vector_type(2)));
typedef unsigned u32x4 __attribute__((ext_vector_type(4)));
typedef __bf16 bf16x2_t __attribute__((ext_vector_type(2)));

constexpr int M_TOK = 32768, DM = 1024, NIN = 5120, SEQ = 4096, NBATCH = 8;
constexpr int C_Q = 0, C_K = 512, C_V = 1024, C_ZA = 1536, C_U = 2048, C_ZS = 2560, C_GA = 3072, C_GS = 4096;
constexpr float NORM_EPS = 1e-6f;
constexpr float LOG2E = 1.4426950408889634f;
constexpr size_t MiB = 1u << 20;
constexpr size_t WS_WIN = 0, WS_WGLU = 10 * MiB, WS_WAO = 11 * MiB, WS_WSO = 12 * MiB, WS_WOUT = 13 * MiB, WS_SSQ = 15 * MiB;
constexpr size_t WS_CTL = 17 * MiB, CTL_ZERO_BYTES = 16384;
constexpr size_t WS_XN = 32 * MiB;
constexpr size_t WS_PROJ = 96 * MiB;
constexpr size_t WS_END = 416 * MiB;
constexpr int LDS_BYTES = 147456;
constexpr int NWAVES = 8;
constexpr int MISC_OFF = 131072 + 64;

__device__ __forceinline__ unsigned cvtpk(float lo, float hi) { f32x2 v = {lo, hi}; bf16x2_t b = __builtin_convertvector(v, bf16x2_t); return __builtin_bit_cast(unsigned, b); }
__device__ __forceinline__ float bflo(unsigned w) { return __uint_as_float(w << 16); }
__device__ __forceinline__ float bfhi(unsigned w) { return __uint_as_float(w & 0xffff0000u); }
__device__ __forceinline__ float sigm(float x) { return __builtin_amdgcn_rcpf(1.f + __builtin_amdgcn_exp2f(-LOG2E * x)); }
__device__ __forceinline__ float silu_f(float x) { return x * sigm(x); }
__device__ __forceinline__ float gelu_tanh_f(float x) { return x * sigm(1.5957691216057308f * (x + 0.044715f * x * x * x)); }
__device__ __forceinline__ float wave_sum(float v) {
#pragma unroll
    for (int o = 1; o < 64; o <<= 1) v += __shfl_xor(v, o);
    return v;
}

namespace pg8 {
constexpr int BM = 256, BK = 64, HALF = 128, HTB = HALF * BK * 2, STAGE_BYTES = 8 * HTB, NXCD = 8, WGM = 8;
__host__ __device__ __forceinline__ int lds_byte(int r, int c) { const int st = (r >> 4) * 2 + (c >> 5), rr = r & 15, cc = c & 31, ob = rr * 64 + cc * 2; return st * 1024 + (ob ^ (((ob >> 9) & 1) << 5)); }
__host__ __device__ __forceinline__ void stage_rc(int b, int& R, int& C) { const int st = b / 1024, sb = b % 1024, swz = sb ^ (((sb >> 9) & 1) << 5); R = (st >> 1) * 16 + swz / 64; C = (st & 1) * 32 + (swz % 64) / 2; }
__host__ __device__ __forceinline__ int perm32(int rho) { const int n = rho >> 4, i = rho & 15; return 8 * (i >> 2) + 4 * n + (i & 3); }

struct Unit { int pm, pn, z; };
struct Gemm { const bf16_t* A0; const bf16_t* A1; const bf16_t* B0; const bf16_t* B1; int lda, K; };

struct StaticOrder {
    int nM, nN, nwg, G, c, nz;
    __device__ void init(int M, int N, int G_, int c_, int nz_) { nM = M / BM; nN = N / BM; nwg = nM * nN; G = G_; c = c_; nz = nz_; }
    __device__ bool next(int i, Unit& u) const {
        const int ti = (nz == 2) ? (i >> 1) : i; u.z = (nz == 2) ? (i & 1) : 0;
        const long L = (long)ti * G + c; if (L >= nwg) return false;
        int wgid = (int)L; { const int q = nwg / NXCD, r = nwg % NXCD, xcd = wgid % NXCD, off = wgid / NXCD; wgid = (xcd < r ? xcd * (q + 1) : r * (q + 1) + (xcd - r) * q) + off; }
        const int nig = WGM * nN, gid = wgid / nig, fm = gid * WGM, gsz = (nM - fm) < WGM ? (nM - fm) : WGM;
        u.pm = fm + ((wgid % nig) % gsz); u.pn = (wgid % nig) / gsz; return true;
    }
};

template <class Epi>
__device__ __forceinline__ void gemm_phase(LAS unsigned char* lds, const Gemm g, const StaticOrder& S, const Epi& E) {
    int tid = threadIdx.x; asm volatile("" : "+v"(tid));
    const int wid = __builtin_amdgcn_readfirstlane(tid >> 6), lane = tid & 63, wr = wid >> 2, wc = wid & 3, fr = lane & 15, fq = lane >> 4;
    const int K = g.K, nt = K / BK, lda = g.lda;
    unsigned voffA[2], voffB[2];
#pragma unroll
    for (int i = 0; i < 2; ++i) { int R, C; stage_rc(tid * 16 + i * 8192, R, C); const int Rb = (R & ~31) + perm32(R & 31);
        voffA[i] = (unsigned)(R * lda + C) * 2u; voffB[i] = (unsigned)(Rb * K + C) * 2u; }
    const size_t kstep = (size_t)(BK * 2);
    const size_t hstepA = (size_t)HALF * lda * 2, tstepA = 2 * hstepA;
    const size_t hstepB = (size_t)HALF * K * 2, tstepB = 2 * hstepB;
    const unsigned ldsw = (unsigned)wid * 1024u;
    const int aoff = lds_byte(wr * 64 + fr, fq * 8), boff = lds_byte(wc * 32 + fr, fq * 8);
#define PG8_SA(b, h) (((b) * 2 + (h)) * HTB)
#define PG8_SB(b, h) ((4 + (b) * 2 + (h)) * HTB)
#define PG8_STAGE(bufoff, gbase, voff) do { _Pragma("unroll") for (int _i = 0; _i < 2; ++_i) \
        __builtin_amdgcn_global_load_lds((const unsigned*)((const char*)(gbase) + (voff)[_i]), (LAS unsigned*)(lds + (bufoff) + ldsw + _i * 8192), 16, 0, 0); } while (0)
#define PG8_LDA(dst, b, h) do { _Pragma("unroll") for (int m = 0; m < 4; ++m) _Pragma("unroll") for (int k = 0; k < 2; ++k) dst[m][k] = *(const LAS bf16x8*)(lds + PG8_SA(b, h) + aoff + m * 2048 + k * 1024); } while (0)
#define PG8_LDB(dst, b, h) do { _Pragma("unroll") for (int n = 0; n < 2; ++n) _Pragma("unroll") for (int k = 0; k < 2; ++k) dst[n][k] = *(const LAS bf16x8*)(lds + PG8_SB(b, h) + boff + n * 2048 + k * 1024); } while (0)
#define PG8_MMA(ai, bj, At, Bt) do { __builtin_amdgcn_s_setprio(1); _Pragma("unroll") for (int m = 0; m < 4; ++m) _Pragma("unroll") for (int n = 0; n < 2; ++n) _Pragma("unroll") for (int k = 0; k < 2; ++k) \
        acc[ai][bj][m][n] = __builtin_amdgcn_mfma_f32_16x16x32_bf16(Bt[n][k], At[m][k], acc[ai][bj][m][n], 0, 0, 0); __builtin_amdgcn_s_setprio(0); } while (0)
#define PG8_WAIT_V(n) asm volatile("s_waitcnt vmcnt(" #n ")" ::: "memory")
#define PG8_WAIT_L(n) asm volatile("s_waitcnt lgkmcnt(" #n ")" ::: "memory")
#define PG8_BAR __builtin_amdgcn_s_barrier()
#define PG8_SCHED __builtin_amdgcn_sched_barrier(0)
    Unit cur, nxt; int ui = 0;
    if (!S.next(0, cur)) return;
    f32x4 acc[2][2][4][2];
#pragma unroll
    for (int a = 0; a < 2; ++a)
#pragma unroll
        for (int b = 0; b < 2; ++b)
#pragma unroll
            for (int m = 0; m < 4; ++m)
#pragma unroll
                for (int n = 0; n < 2; ++n) acc[a][b][m][n] = (f32x4){0.f, 0.f, 0.f, 0.f};
    bf16x8 At[4][2], B0[2][2], B1[2][2];
    const char* cA = (const char*)(cur.z ? g.A1 : g.A0) + (size_t)cur.pm * tstepA; const char* cB = (const char*)(cur.z ? g.B1 : g.B0) + (size_t)cur.pn * tstepB;
    PG8_STAGE(PG8_SB(0, 0), cB, voffB); PG8_STAGE(PG8_SB(0, 1), cB + hstepB, voffB); PG8_STAGE(PG8_SA(0, 0), cA, voffA); PG8_STAGE(PG8_SA(0, 1), cA + hstepA, voffA);
    if (wr == 1) PG8_BAR;
    PG8_WAIT_V(2); PG8_BAR;
    PG8_STAGE(PG8_SB(1, 0), cB + kstep, voffB); PG8_STAGE(PG8_SA(1, 0), cA + kstep, voffA); PG8_STAGE(PG8_SB(1, 1), cB + hstepB + kstep, voffB);
    PG8_WAIT_V(6); PG8_BAR;
    for (;;) {
        const bool has_next = S.next(ui + 1, nxt);
        const char* nA = has_next ? (const char*)(nxt.z ? g.A1 : g.A0) + (size_t)nxt.pm * tstepA : cA; const char* nB = has_next ? (const char*)(nxt.z ? g.B1 : g.B0) + (size_t)nxt.pn * tstepB : cB;
        for (int t = 0; t < nt; t += 2) {
            const bool last = (t == nt - 2);
            const char* a1 = cA + (size_t)(t + 1) * kstep;
            const char* a2 = last ? nA : cA + (size_t)(t + 2) * kstep; const char* b2 = last ? nB : cB + (size_t)(t + 2) * kstep;
            const char* a3 = a2 + kstep; const char* b3 = b2 + kstep;
            PG8_LDB(B0, 0, 0); PG8_LDB(B1, 0, 1); PG8_SCHED; PG8_LDA(At, 0, 0); PG8_STAGE(PG8_SA(1, 1), a1 + hstepA, voffA);
            PG8_WAIT_V(8); PG8_WAIT_L(0); PG8_BAR; PG8_MMA(0, 0, At, B0); PG8_MMA(0, 1, At, B1); PG8_BAR; PG8_SCHED;
            PG8_LDA(At, 0, 1); PG8_STAGE(PG8_SB(0, 0), b2, voffB); PG8_STAGE(PG8_SB(0, 1), b2 + hstepB, voffB); PG8_STAGE(PG8_SA(0, 0), a2, voffA);
            PG8_WAIT_V(8); PG8_WAIT_L(0); PG8_BAR; PG8_MMA(1, 0, At, B0); PG8_MMA(1, 1, At, B1); PG8_BAR; PG8_SCHED;
            PG8_LDB(B0, 1, 0); PG8_LDB(B1, 1, 1); PG8_SCHED; PG8_LDA(At, 1, 0); PG8_STAGE(PG8_SA(0, 1), a2 + hstepA, voffA);
            PG8_WAIT_V(8); PG8_WAIT_L(0); PG8_BAR; PG8_MMA(0, 0, At, B0); PG8_MMA(0, 1, At, B1); PG8_BAR; PG8_SCHED;
            PG8_LDA(At, 1, 1); PG8_STAGE(PG8_SB(1, 0), b3, voffB); PG8_STAGE(PG8_SB(1, 1), b3 + hstepB, voffB); PG8_STAGE(PG8_SA(1, 0), a3, voffA);
            PG8_WAIT_V(8); PG8_WAIT_L(0); PG8_BAR; PG8_MMA(1, 0, At, B0); PG8_MMA(1, 1, At, B1); PG8_BAR; PG8_SCHED;
        }
        if (wr == 0) PG8_BAR;
        E(acc, cur, wr, wc, fr, fq);
        if (!has_next) break;
#pragma unroll
        for (int a = 0; a < 2; ++a)
#pragma unroll
            for (int b = 0; b < 2; ++b)
#pragma unroll
                for (int m = 0; m < 4; ++m)
#pragma unroll
                    for (int n = 0; n < 2; ++n) acc[a][b][m][n] = (f32x4){0.f, 0.f, 0.f, 0.f};
        cur = nxt; cA = nA; cB = nB; ++ui;
        if (wr == 1) PG8_BAR;
    }
    PG8_WAIT_V(0);
    PG8_BAR;
#undef PG8_SA
#undef PG8_SB
#undef PG8_STAGE
#undef PG8_LDA
#undef PG8_LDB
#undef PG8_MMA
#undef PG8_WAIT_V
#undef PG8_WAIT_L
#undef PG8_BAR
#undef PG8_SCHED
}

struct EpiProj {
    bf16_t* O; const float* gate_bias;
    __device__ __forceinline__ void operator()(const f32x4 (&acc)[2][2][4][2], const Unit& u, int wr, int wc, int fr, int fq) const {
        const int pn = u.pn;
        const int mode = (pn < 2) ? 1 : (pn < 6) ? 0 : (pn < 8) ? 2 : (pn < 10) ? 0 : (pn < 12) ? 2 : 3;
        const int row0 = u.pm * BM + wr * 64 + fr, col0 = pn * BM + wc * 32 + 8 * fq;
        f32x4 bv[2][2];
#pragma unroll
        for (int bj = 0; bj < 2; ++bj)
#pragma unroll
            for (int n = 0; n < 2; ++n) bv[bj][n] = (mode == 3) ? *(const f32x4*)(gate_bias + (col0 - C_GA) + bj * HALF + 4 * n) : (f32x4){0.f, 0.f, 0.f, 0.f};
#pragma unroll
        for (int ai = 0; ai < 2; ++ai)
#pragma unroll
            for (int m = 0; m < 4; ++m) { bf16_t* rowp = O + (size_t)(row0 + ai * HALF + m * 16) * NIN + col0;
#pragma unroll
                for (int bj = 0; bj < 2; ++bj) { f32x4 v0 = acc[ai][bj][m][0], v1 = acc[ai][bj][m][1];
                    if (mode == 1) { v0 = v0 * (0.125f * LOG2E); v1 = v1 * (0.125f * LOG2E); }
                    else if (mode == 2) {
#pragma unroll
                        for (int i = 0; i < 4; ++i) { v0[i] = silu_f(v0[i]); v1[i] = silu_f(v1[i]); } }
                    else if (mode == 3) { v0 = v0 + bv[bj][0]; v1 = v1 + bv[bj][1];
#pragma unroll
                        for (int i = 0; i < 4; ++i) { v0[i] = sigm(v0[i]); v1[i] = sigm(v1[i]); } }
                    u32x4 w; w.x = cvtpk(v0[0], v0[1]); w.y = cvtpk(v0[2], v0[3]); w.z = cvtpk(v1[0], v1[1]); w.w = cvtpk(v1[2], v1[3]);
                    *(u32x4*)(rowp + bj * HALF) = w; } }
    }
};
struct EpiGlu {
    bf16_t* P; const float* b_glu;
    __device__ __forceinline__ void operator()(const f32x4 (&acc)[2][2][4][2], const Unit& u, int wr, int wc, int fr, int fq) const {
        const int row0 = u.pm * BM + wr * 64 + fr, j0 = u.pn * HALF + wc * 32 + 8 * fq;
        f32x4 ba[2], bb[2];
#pragma unroll
        for (int n = 0; n < 2; ++n) { ba[n] = *(const f32x4*)(b_glu + j0 + 4 * n); bb[n] = *(const f32x4*)(b_glu + 512 + j0 + 4 * n); }
#pragma unroll
        for (int ai = 0; ai < 2; ++ai)
#pragma unroll
            for (int m = 0; m < 4; ++m) { bf16_t* zp = P + (size_t)(row0 + ai * HALF + m * 16) * NIN + C_ZS + j0;
                const u32x4 z = *(const u32x4*)zp; float r[8];
#pragma unroll
                for (int n = 0; n < 2; ++n) { const f32x4 a = acc[ai][0][m][n] + ba[n], b = acc[ai][1][m][n] + bb[n];
#pragma unroll
                    for (int i = 0; i < 4; ++i) r[4 * n + i] = a[i] * sigm(b[i]); }
                u32x4 w; w.x = cvtpk(r[0] * bflo(z.x), r[1] * bfhi(z.x)); w.y = cvtpk(r[2] * bflo(z.y), r[3] * bfhi(z.y));
                w.z = cvtpk(r[4] * bflo(z.z), r[5] * bfhi(z.z)); w.w = cvtpk(r[6] * bflo(z.w), r[7] * bfhi(z.w));
                *(u32x4*)zp = w; }
    }
};
struct EpiMerge {
    const bf16_t* P; float* tmp; bf16_t* MG;
    __device__ __forceinline__ void operator()(const f32x4 (&acc)[2][2][4][2], const Unit& u, int wr, int wc, int fr, int fq) const {
        const int row0 = u.pm * BM + wr * 64 + fr, col0 = u.pn * BM + wc * 32 + 8 * fq;
#pragma unroll
        for (int ai = 0; ai < 2; ++ai)
#pragma unroll
            for (int m = 0; m < 4; ++m) { const size_t row = (size_t)(row0 + ai * HALF + m * 16);
#pragma unroll
                for (int bj = 0; bj < 2; ++bj) { const int col = col0 + bj * HALF;
                    const u32x4 gt = *(const u32x4*)(P + row * NIN + (u.z ? C_GS : C_GA) + col);
                    f32x4 v0 = acc[ai][bj][m][0], v1 = acc[ai][bj][m][1];
                    v0[0] *= bflo(gt.x); v0[1] *= bfhi(gt.x); v0[2] *= bflo(gt.y); v0[3] *= bfhi(gt.y);
                    v1[0] *= bflo(gt.z); v1[1] *= bfhi(gt.z); v1[2] *= bflo(gt.w); v1[3] *= bfhi(gt.w);
                    float* tp = tmp + row * DM + col;
                    if (u.z == 0) { *(f32x4*)tp = v0; *(f32x4*)(tp + 4) = v1; }
                    else { v0 = v0 + *(const f32x4*)tp; v1 = v1 + *(const f32x4*)(tp + 4);
                        u32x4 w; w.x = cvtpk(v0[0], v0[1]); w.y = cvtpk(v0[2], v0[3]); w.z = cvtpk(v1[0], v1[1]); w.w = cvtpk(v1[2], v1[3]);
                        *(u32x4*)(MG + row * DM + col) = w; } } }
    }
};
struct EpiOut {
    const float* x; float* out; float* ssq;
    __device__ __forceinline__ void operator()(const f32x4 (&acc)[2][2][4][2], const Unit& u, int wr, int wc, int fr, int fq) const {
        const int row0 = u.pm * BM + wr * 64 + fr, col0 = u.pn * BM + wc * 32 + 8 * fq;
#pragma unroll
        for (int ai = 0; ai < 2; ++ai)
#pragma unroll
            for (int m = 0; m < 4; ++m) { const size_t row = (size_t)(row0 + ai * HALF + m * 16); float s = 0.f;
#pragma unroll
                for (int bj = 0; bj < 2; ++bj) { const size_t o = row * DM + col0 + bj * HALF;
                    const f32x4 v0 = acc[ai][bj][m][0] + *(const f32x4*)(x + o), v1 = acc[ai][bj][m][1] + *(const f32x4*)(x + o + 4);
                    *(f32x4*)(out + o) = v0; *(f32x4*)(out + o + 4) = v1;
                    s += (v0[0] * v0[0] + v0[1] * v0[1]) + (v0[2] * v0[2] + v0[3] * v0[3]) + (v1[0] * v1[0] + v1[1] * v1[1]) + (v1[2] * v1[2] + v1[3] * v1[3]); }
                s += __shfl_xor(s, 16); s += __shfl_xor(s, 32);
                if (fq == 0) ssq[row * 16 + u.pn * 4 + wc] = s; }
    }
};
}

__device__ __forceinline__ void p0_transpose_item(const float* W, int K, int N, bf16_t* WT, bool glu_map, LAS float* scr, int item, int lane) {
    const int nblk = N / 32, kb = item / nblk, nb = item % nblk, k0 = 64 * kb, n0 = 32 * nb;
    int r0 = n0;
    if (glu_map) { const int bj = n0 >> 9, rem = n0 & 511, pn = rem >> 7, w = rem & 127; r0 = 256 * pn + 128 * bj + w; }
#pragma unroll 8
    for (int i = 0; i < 32; ++i) { const int kk = 2 * i + (lane >> 5); scr[kk * 33 + (lane & 31)] = W[(size_t)(k0 + kk) * N + n0 + (lane & 31)]; }
    asm volatile("s_waitcnt lgkmcnt(0)" ::: "memory");
    const int c = lane & 7;
#pragma unroll
    for (int j = 0; j < 4; ++j) { const int n = (lane >> 3) + 8 * j; const LAS float* s = scr + (8 * c) * 33 + n;
        u32x4 o; o.x = cvtpk(s[0 * 33], s[1 * 33]); o.y = cvtpk(s[2 * 33], s[3 * 33]); o.z = cvtpk(s[4 * 33], s[5 * 33]); o.w = cvtpk(s[6 * 33], s[7 * 33]);
        *(u32x4*)(WT + (size_t)(r0 + n) * K + k0 + 8 * c) = o; }
    asm volatile("s_waitcnt lgkmcnt(0)" ::: "memory");
}

__device__ __forceinline__ void sincos_acc(float th, float& s, float& c) {
    const float k = rintf(th * 0.636619772f);
    float r = fmaf(-k, 1.57079637050628662109375f, th); r = fmaf(-k, -4.371139000186241e-08f, r);
    const int q = ((int)k) & 3; const float r2 = r * r;
    const float sp = r * (1.f + r2 * (-1.66666667e-1f + r2 * (8.33333333e-3f + r2 * (-1.98412698e-4f + r2 * 2.75573192e-6f))));
    const float cp = 1.f + r2 * (-0.5f + r2 * (4.16666667e-2f + r2 * (-1.38888889e-3f + r2 * (2.48015873e-5f + r2 * -2.75573192e-7f))));
    s = (q == 0) ? sp : (q == 1) ? cp : (q == 2) ? -sp : -cp;
    c = (q == 0) ? cp : (q == 1) ? -sp : (q == 2) ? -cp : sp;
}
struct SsmIn { const float *a_re, *a_im, *log_dt, *b_re, *b_im, *c_re, *c_im, *d; };
constexpr int SSM_HROW = 272;
constexpr int SSM_HTILE = 32 * SSM_HROW;
constexpr int SSM_E_OFF = NWAVES * SSM_HTILE;

__device__ __forceinline__ void ssm_unit(int b, int g, bf16_t* PROJ, const SsmIn& si, LAS unsigned char* lds, int wave, int lane) {
    asm volatile("" : "+v"(lane));
    const int n = lane & 31, hi = lane >> 5;
    const float dt = expf(si.log_dt[g]);
    float ar[2], ai[2], fre[2], fim[2];
#pragma unroll
    for (int s = 0; s < 2; ++s) { const int p = 32 * s + n;
        const float lre = si.a_re[g * 64 + p], lim = si.a_im[g * 64 + p];
        const float xx = lre * dt, th = lim * dt;
        const float em1 = xx * (1.f + xx * 0.5f * (1.f + xx * (1.f / 3.f) * (1.f + xx * 0.25f * (1.f + xx * 0.2f * (1.f + xx * (1.f / 6.f) * (1.f + xx * (1.f / 7.f)))))));
        const float mag = 1.f + em1;
        float sn, cs, sh, ch; sincos_acc(th, sn, cs); sincos_acc(0.5f * th, sh, ch);
        const float cm1 = -2.f * sh * sh;
        ar[s] = mag * cs; ai[s] = mag * sn;
        const float nre = em1 * cs + cm1, nim = mag * sn, den = lre * lre + lim * lim;
        fre[s] = (nre * lre + nim * lim) / den; fim[s] = (nim * lre - nre * lim) / den; }
    bf16x8 Bf[4];
#pragma unroll
    for (int s = 0; s < 2; ++s) { const int p = 32 * s + n; const float* br = si.b_re + ((size_t)(g * 64 + p)) * 16 + 8 * hi; const float* bi = si.b_im + ((size_t)(g * 64 + p)) * 16 + 8 * hi;
        float vr[8], vi[8];
#pragma unroll
        for (int j = 0; j < 8; ++j) { const float r_ = br[j], i_ = bi[j]; vr[j] = fre[s] * r_ - fim[s] * i_; vi[j] = fre[s] * i_ + fim[s] * r_; }
        u32x4 wr_, wi_; wr_.x = cvtpk(vr[0], vr[1]); wr_.y = cvtpk(vr[2], vr[3]); wr_.z = cvtpk(vr[4], vr[5]); wr_.w = cvtpk(vr[6], vr[7]);
        wi_.x = cvtpk(vi[0], vi[1]); wi_.y = cvtpk(vi[2], vi[3]); wi_.z = cvtpk(vi[4], vi[5]); wi_.w = cvtpk(vi[6], vi[7]);
        Bf[2 * s] = __builtin_bit_cast(bf16x8, wr_); Bf[2 * s + 1] = __builtin_bit_cast(bf16x8, wi_); }
    bf16x8 Cf[4];
    { const int c = lane & 15, q4 = lane >> 4;
#pragma unroll
        for (int ks = 0; ks < 4; ++ks) { float v[8];
#pragma unroll
            for (int j = 0; j < 8; ++j) { const int np = 8 * ks + 2 * q4 + (j >> 2), cb = j & 3; const int p = np + 32 * (cb >> 1);
                v[j] = (cb & 1) ? -si.c_im[((size_t)(g * 16 + c)) * 64 + p] : si.c_re[((size_t)(g * 16 + c)) * 64 + p]; }
            u32x4 w; w.x = cvtpk(v[0], v[1]); w.y = cvtpk(v[2], v[3]); w.z = cvtpk(v[4], v[5]); w.w = cvtpk(v[6], v[7]);
            Cf[ks] = __builtin_bit_cast(bf16x8, w); } }
    const int rho = n, ho = (rho >> 2) & 1, rr = (rho & 3) + 4 * (rho >> 3);
    bf16_t* ubase = PROJ + ((size_t)b * SEQ + 256 * (2 * wave + ho) + rr) * NIN + C_U + 16 * g + 8 * hi;
    LAS float* E = (LAS float*)(lds + SSM_E_OFF);
    const f32x16 z16 = {0.f, 0.f, 0.f, 0.f, 0.f, 0.f, 0.f, 0.f, 0.f, 0.f, 0.f, 0.f, 0.f, 0.f, 0.f, 0.f};
    float hre[2] = {0.f, 0.f}, him[2] = {0.f, 0.f};
    {
        bf16x8 uf = *(const bf16x8*)ubase;
        for (int blk = 0; blk < 16; ++blk) {
            bf16x8 ufn = uf; if (blk < 15) ufn = *(const bf16x8*)(ubase + (size_t)(16 * (blk + 1)) * NIN);
            f32x16 a4[4];
#pragma unroll
            for (int cb = 0; cb < 4; ++cb) a4[cb] = __builtin_amdgcn_mfma_f32_32x32x16_bf16(uf, Bf[cb], z16, 0, 0, 0);
#pragma unroll
            for (int r = 0; r < 16; ++r) {
#pragma unroll
                for (int s = 0; s < 2; ++s) { const float tr = fmaf(-ai[s], him[s], a4[2 * s][r]), ti = fmaf(ai[s], hre[s], a4[2 * s + 1][r]);
                    hre[s] = fmaf(ar[s], hre[s], tr); him[s] = fmaf(ar[s], him[s], ti); } }
            uf = ufn;
        }
        const int ss = 2 * wave + hi;
        E[ss * 128 + 0 * 32 + n] = hre[0]; E[ss * 128 + 1 * 32 + n] = him[0]; E[ss * 128 + 2 * 32 + n] = hre[1]; E[ss * 128 + 3 * 32 + n] = him[1];
    }
    __syncthreads();
    {
        float pr[2], pi[2];
#pragma unroll
        for (int s = 0; s < 2; ++s) { pr[s] = ar[s]; pi[s] = ai[s];
#pragma unroll
            for (int i = 0; i < 8; ++i) { const float t = pr[s] * pr[s] - pi[s] * pi[s]; pi[s] = 2.f * pr[s] * pi[s]; pr[s] = t; } }
        const int ss = 2 * wave + hi;
        hre[0] = hre[1] = him[0] = him[1] = 0.f;
        for (int k = 0; k < 15; ++k) { if (k < ss) {
#pragma unroll
                for (int s = 0; s < 2; ++s) { const float er = E[k * 128 + (2 * s) * 32 + n], ei = E[k * 128 + (2 * s + 1) * 32 + n];
                    const float t = pr[s] * hre[s] - pi[s] * him[s] + er; him[s] = pr[s] * him[s] + pi[s] * hre[s] + ei; hre[s] = t; } } }
    }
    {
        LAS unsigned char* Ht = lds + wave * SSM_HTILE;
        const int tk = lane & 15, q4 = lane >> 4;
        f32x4 dsk = *(const f32x4*)(si.d + 16 * g + 4 * q4);
        bf16x8 uf = *(const bf16x8*)ubase;
        bf16_t* up0 = PROJ + ((size_t)b * SEQ + 256 * (2 * wave) + tk) * NIN + C_U + 16 * g + 4 * q4;
        u32x2 uuc[2] = {*(const u32x2*)up0, *(const u32x2*)(up0 + (size_t)256 * NIN)};
        for (int blk = 0; blk < 16; ++blk) {
            bf16x8 ufn = uf; u32x2 uun[2] = {uuc[0], uuc[1]};
            if (blk < 15) { ufn = *(const bf16x8*)(ubase + (size_t)(16 * (blk + 1)) * NIN);
                uun[0] = *(const u32x2*)(up0 + (size_t)(16 * (blk + 1)) * NIN); uun[1] = *(const u32x2*)(up0 + (size_t)(256 + 16 * (blk + 1)) * NIN); }
            f32x16 a4[4];
#pragma unroll
            for (int cb = 0; cb < 4; ++cb) a4[cb] = __builtin_amdgcn_mfma_f32_32x32x16_bf16(uf, Bf[cb], z16, 0, 0, 0);
#pragma unroll
            for (int r = 0; r < 16; ++r) {
#pragma unroll
                for (int s = 0; s < 2; ++s) { const float tr = fmaf(-ai[s], him[s], a4[2 * s][r]), ti = fmaf(ai[s], hre[s], a4[2 * s + 1][r]);
                    hre[s] = fmaf(ar[s], hre[s], tr); him[s] = fmaf(ar[s], him[s], ti); }
                u32x2 w; w.x = cvtpk(hre[0], him[0]); w.y = cvtpk(hre[1], him[1]);
                *(LAS u32x2*)(Ht + (16 * hi + r) * SSM_HROW + 8 * n) = w; }
            asm volatile("s_waitcnt lgkmcnt(0)" ::: "memory");
#pragma unroll
            for (int tb = 0; tb < 2; ++tb) {
                f32x4 y = {0.f, 0.f, 0.f, 0.f};
#pragma unroll
                for (int ks = 0; ks < 4; ++ks) { const bf16x8 hb = *(const LAS bf16x8*)(Ht + (16 * tb + tk) * SSM_HROW + (32 * ks + 8 * q4) * 2);
                    y = __builtin_amdgcn_mfma_f32_16x16x32_bf16(Cf[ks], hb, y, 0, 0, 0); }
                bf16_t* up = up0 + (size_t)(256 * tb + 16 * blk) * NIN;
                const u32x2 uu = uuc[tb];
                const float y0 = gelu_tanh_f(y[0] + dsk[0] * bflo(uu.x)), y1 = gelu_tanh_f(y[1] + dsk[1] * bfhi(uu.x));
                const float y2 = gelu_tanh_f(y[2] + dsk[2] * bflo(uu.y)), y3 = gelu_tanh_f(y[3] + dsk[3] * bfhi(uu.y));
                u32x2 w; w.x = cvtpk(y0, y1); w.y = cvtpk(y2, y3);
                *(u32x2*)up = w;
            }
            asm volatile("s_waitcnt lgkmcnt(0)" ::: "memory");
            uf = ufn; uuc[0] = uun[0]; uuc[1] = uun[1];
        }
    }
    __syncthreads();
}

constexpr int ATT_WAVE_LDS = 2 * 4096 + 1024;
__device__ __forceinline__ void attn_build_table(const float* rel_bias, int h, LAS unsigned char* wl, int lane) {
    LAS float* T = (LAS float*)(wl + 8192);
    const float c0 = rel_bias[h * 192 + 191];
#pragma unroll
    for (int i = 0; i < 4; ++i) { const int idx = lane + 64 * i; T[idx] = (idx < 191) ? (rel_bias[h * 192 + idx] - c0) * LOG2E : 0.f; }
    asm volatile("s_waitcnt lgkmcnt(0)" ::: "memory");
}
__device__ __forceinline__ void attn_unit(int b, int nchunk, int h, bf16_t* PROJ, LAS unsigned char* wl, int lane) {
    asm volatile("" : "+v"(lane));
    const int q32 = lane & 31, hi = lane >> 5;
    const LAS float* T = (const LAS float*)(wl + 8192);
    const size_t tok0 = (size_t)b * SEQ + (size_t)nchunk * 64;
    bf16x8 qf[2][4];
#pragma unroll
    for (int qb = 0; qb < 2; ++qb)
#pragma unroll
        for (int ds = 0; ds < 4; ++ds) qf[qb][ds] = *(const bf16x8*)(PROJ + (tok0 + 32 * qb + q32) * NIN + C_Q + h * 64 + 16 * ds + 8 * hi);
    f32x16 o[2][2];
#pragma unroll
    for (int db = 0; db < 2; ++db)
#pragma unroll
        for (int qb = 0; qb < 2; ++qb)
#pragma unroll
            for (int r = 0; r < 16; ++r) o[db][qb][r] = 0.f;
    float mrun[2] = {-1e30f, -1e30f}, lrun[2] = {0.f, 0.f};
    const int j0 = (nchunk < 8) ? (8 - nchunk) : 0;
    const int t0 = 2 * j0;
#define KTOK(t) ((size_t)b * SEQ + (size_t)(nchunk - 8 + ((t) >> 1)) * 64 + 32 * ((t) & 1))
    bf16x8 kf[4]; u32x4 vch[4];
    { const size_t kt = KTOK(t0);
#pragma unroll
        for (int ds = 0; ds < 4; ++ds) kf[ds] = *(const bf16x8*)(PROJ + (kt + q32) * NIN + C_K + h * 64 + 16 * ds + 8 * hi);
#pragma unroll
        for (int i = 0; i < 4; ++i) { const int cc = lane + 64 * i, key = cc >> 3, c8 = cc & 7; vch[i] = *(const u32x4*)(PROJ + (kt + key) * NIN + C_V + h * 64 + 8 * c8); }
#pragma unroll
        for (int i = 0; i < 4; ++i) { const int cc = lane + 64 * i, key = cc >> 3, c8 = cc & 7; *(LAS u32x4*)(wl + (t0 & 1) * 4096 + (c8 >> 2) * 2048 + key * 64 + (c8 & 3) * 16) = vch[i]; }
    }
    const int gI = lane >> 4, li = lane & 15, qrow = li >> 2, pp = li & 3;
    const int vtr_off = (4 * hi + qrow) * 64 + (16 * (gI & 1) + 4 * pp) * 2;
    for (int t = t0; t < 18; ++t) {
        bf16x8 kfn[4];
        const bool more = (t + 1 < 18);
        if (more) { const size_t kt = KTOK(t + 1);
#pragma unroll
            for (int ds = 0; ds < 4; ++ds) kfn[ds] = *(const bf16x8*)(PROJ + (kt + q32) * NIN + C_K + h * 64 + 16 * ds + 8 * hi);
#pragma unroll
            for (int i = 0; i < 4; ++i) { const int cc = lane + 64 * i, key = cc >> 3, c8 = cc & 7; vch[i] = *(const u32x4*)(PROJ + (kt + key) * NIN + C_V + h * 64 + 8 * c8); }
        } else {
#pragma unroll
            for (int ds = 0; ds < 4; ++ds) kfn[ds] = kf[ds];
        }
        const int j = t >> 1, kb = t & 1;
        f32x16 s[2];
        if (j >= 6) {
#pragma unroll
            for (int qb = 0; qb < 2; ++qb) { const int base = 32 * qb + q32 - 32 * kb - 4 * hi + 64 * (8 - j) + 63;
#pragma unroll
                for (int r = 0; r < 16; ++r) s[qb][r] = T[base - ((r & 3) + 8 * (r >> 2))]; }
        } else {
#pragma unroll
            for (int qb = 0; qb < 2; ++qb)
#pragma unroll
                for (int r = 0; r < 16; ++r) s[qb][r] = 0.f;
        }
#pragma unroll
        for (int ds = 0; ds < 4; ++ds)
#pragma unroll
            for (int qb = 0; qb < 2; ++qb) s[qb] = __builtin_amdgcn_mfma_f32_32x32x16_bf16(kf[ds], qf[qb][ds], s[qb], 0, 0, 0);
        bf16x8 pf[2][2];
#pragma unroll
        for (int qb = 0; qb < 2; ++qb) {
            float mx = s[qb][0];
#pragma unroll
            for (int r = 1; r < 16; ++r) mx = fmaxf(mx, s[qb][r]);
            mx = fmaxf(mx, __shfl_xor(mx, 32));
            const float mnew = fmaxf(mrun[qb], mx);
            const float alpha = __builtin_amdgcn_exp2f(mrun[qb] - mnew);
            mrun[qb] = mnew;
            float ls = 0.f;
#pragma unroll
            for (int r = 0; r < 16; ++r) { const float p = __builtin_amdgcn_exp2f(s[qb][r] - mnew); s[qb][r] = p; ls += p; }
            lrun[qb] = lrun[qb] * alpha + ls;
#pragma unroll
            for (int db = 0; db < 2; ++db)
#pragma unroll
                for (int r = 0; r < 16; ++r) o[db][qb][r] *= alpha;
#pragma unroll
            for (int s2 = 0; s2 < 2; ++s2) { u32x4 w; w.x = cvtpk(s[qb][8 * s2 + 0], s[qb][8 * s2 + 1]); w.y = cvtpk(s[qb][8 * s2 + 2], s[qb][8 * s2 + 3]);
                w.z = cvtpk(s[qb][8 * s2 + 4], s[qb][8 * s2 + 5]); w.w = cvtpk(s[qb][8 * s2 + 6], s[qb][8 * s2 + 7]); pf[qb][s2] = __builtin_bit_cast(bf16x8, w); }
        }
        asm volatile("s_waitcnt lgkmcnt(0)" ::: "memory");
        { LAS unsigned char* vb = wl + (t & 1) * 4096 + vtr_off;
#pragma unroll
            for (int db = 0; db < 2; ++db)
#pragma unroll
                for (int s2 = 0; s2 < 2; ++s2) {
                    const s16x4 lo = __builtin_bit_cast(s16x4, __builtin_amdgcn_ds_read_tr16_b64_v4i16((LAS s16x4*)(vb + db * 2048 + (16 * s2) * 64)));
                    const s16x4 hh = __builtin_bit_cast(s16x4, __builtin_amdgcn_ds_read_tr16_b64_v4i16((LAS s16x4*)(vb + db * 2048 + (16 * s2 + 8) * 64)));
                    const bf16x8 vf = {lo[0], lo[1], lo[2], lo[3], hh[0], hh[1], hh[2], hh[3]};
#pragma unroll
                    for (int qb = 0; qb < 2; ++qb) o[db][qb] = __builtin_amdgcn_mfma_f32_32x32x16_bf16(vf, pf[qb][s2], o[db][qb], 0, 0, 0);
                } }
        asm volatile("s_waitcnt lgkmcnt(0)" ::: "memory");
        if (more) {
#pragma unroll
            for (int i = 0; i < 4; ++i) { const int cc = lane + 64 * i, key = cc >> 3, c8 = cc & 7; *(LAS u32x4*)(wl + ((t + 1) & 1) * 4096 + (c8 >> 2) * 2048 + key * 64 + (c8 & 3) * 16) = vch[i]; }
        }
#pragma unroll
        for (int ds = 0; ds < 4; ++ds) kf[ds] = kfn[ds];
    }
#undef KTOK
#pragma unroll
    for (int qb = 0; qb < 2; ++qb) {
        const float lt = lrun[qb] + __shfl_xor(lrun[qb], 32);
        const float inv = 1.0f / lt;
        bf16_t* rowp = PROJ + (tok0 + 32 * qb + q32) * NIN + h * 64;
#pragma unroll
        for (int db = 0; db < 2; ++db)
#pragma unroll
            for (int g4 = 0; g4 < 4; ++g4) { const int d0 = 32 * db + 8 * g4 + 4 * hi;
                const u32x2 za = *(const u32x2*)(rowp + C_ZA + d0);
                u32x2 w; w.x = cvtpk(o[db][qb][4 * g4 + 0] * inv * bflo(za.x), o[db][qb][4 * g4 + 1] * inv * bfhi(za.x));
                w.y = cvtpk(o[db][qb][4 * g4 + 2] * inv * bflo(za.y), o[db][qb][4 * g4 + 3] * inv * bfhi(za.y));
                *(u32x2*)(rowp + C_Q + d0) = w; }
    }
    asm volatile("s_waitcnt lgkmcnt(0)" ::: "memory");
}

#define XB_TMO      128
#define XB_XCNT(j)  (256  + 64 * (j))
#define XB_XSUB(j)  (1280 + 64 * (j))
#define XB_XGEN(j)  (2304 + 64 * (j))
#define XB_TOP      3328
#define XB_TOPGEN   3392
#define XCD_BAR_WORDS 3456
#define XB_SPIN_CAP (1u << 20)
__device__ __forceinline__ unsigned xb_ld(unsigned* p)              { return __hip_atomic_load(p, __ATOMIC_RELAXED, __HIP_MEMORY_SCOPE_AGENT); }
__device__ __forceinline__ unsigned xb_add(unsigned* p, unsigned v) { return __hip_atomic_fetch_add(p, v, __ATOMIC_RELAXED, __HIP_MEMORY_SCOPE_AGENT); }
__device__ __forceinline__ unsigned xb_xcc_id() { return (unsigned)__builtin_amdgcn_s_getreg((3 << 11) | 20) & 0xFu; }
#define XB_SPIN(cond, bar) do { unsigned _sp = 0; while (cond) { __builtin_amdgcn_s_sleep(1); \
    if ((++_sp & 255u) == 0u) { if (xb_ld(&(bar)[XB_TMO])) break; if (_sp > XB_SPIN_CAP) { atomicAdd(&(bar)[XB_TMO], 1u); break; } } } } while (0)
struct XcdBarrier { unsigned* bar; unsigned x; volatile LAS unsigned* st; };
__device__ __forceinline__ XcdBarrier xcd_barrier_post(unsigned* bar, volatile LAS unsigned* st) {
    XcdBarrier b; b.bar = bar; b.x = xb_xcc_id(); b.st = st;
    if (threadIdx.x == 0) (void)xb_add(&bar[XB_XCNT(b.x)], 1u);
    return b;
}
__device__ __forceinline__ void xcd_barrier_complete(unsigned* bar, unsigned x, unsigned& nloc, unsigned& nx) {
    const unsigned G = gridDim.x * gridDim.y * gridDim.z;
    unsigned sum, cnt, mine, sp = 0u;
    for (;;) {
        sum = 0u; cnt = 0u; mine = 0u;
#pragma unroll
        for (unsigned j = 0; j < 16; ++j) { const unsigned c = xb_ld(&bar[XB_XCNT(j)]); sum += c; cnt += (c > 0u) ? 1u : 0u; mine = (j == x) ? c : mine; }
        if (sum == G) break;
        __builtin_amdgcn_s_sleep(1);
        if ((++sp & 255u) == 0u) { if (xb_ld(&bar[XB_TMO])) break; if (sp > XB_SPIN_CAP) { atomicAdd(&bar[XB_TMO], 1u); break; } }
    }
    nloc = mine > 0u ? mine : 1u; nx = cnt > 0u ? cnt : 1u;
}
__device__ __forceinline__ void xcd_barrier(const XcdBarrier& b) {
    asm volatile("s_waitcnt vmcnt(0)" ::: "memory");
    __syncthreads();
    if (threadIdx.x == 0) {
        unsigned* bar = b.bar;
        __builtin_amdgcn_s_waitcnt(0);
        unsigned nloc = b.st[0], nx = b.st[1];
        if (nloc == 0u) { xcd_barrier_complete(bar, b.x, nloc, nx); b.st[0] = nloc; b.st[1] = nx; }
        const unsigned old = xb_add(&bar[XB_XSUB(b.x)], 1u);
        const unsigned gen = old / nloc;
        if (old + 1u == (gen + 1u) * nloc) {
            __builtin_amdgcn_fence(__ATOMIC_RELEASE, "agent");
            asm volatile("s_waitcnt vmcnt(0)" ::: "memory");
            const unsigned og = xb_add(&bar[XB_TOP], 1u);
            const unsigned tg = og / nx;
            if (og + 1u == (tg + 1u) * nx) xb_add(&bar[XB_TOPGEN], 1u);
            else XB_SPIN(xb_ld(&bar[XB_TOPGEN]) == tg, bar);
            __builtin_amdgcn_fence(__ATOMIC_ACQUIRE, "agent");
            xb_add(&bar[XB_XGEN(b.x)], 1u);
            asm volatile("s_waitcnt vmcnt(0)" ::: "memory");
        } else {
            XB_SPIN(xb_ld(&bar[XB_XGEN(b.x)]) == gen, bar);
            __builtin_amdgcn_fence(__ATOMIC_ACQUIRE, "agent");
            asm volatile("s_waitcnt vmcnt(0)" ::: "memory");
        }
    }
    __syncthreads();
}

struct Args {
    const float* in[19]; float* out; unsigned char* ws; int use_cg; int pad;
};

__global__ void __launch_bounds__(NWAVES * 64, 2) fwd_megakernel(Args a) {
    extern __shared__ __attribute__((aligned(16))) unsigned char lds_raw[];
    LAS unsigned char* lds = (LAS unsigned char*)lds_raw;
    cg::grid_group grid = cg::this_grid();
    const int tid = threadIdx.x, lane = tid & 63, wave = __builtin_amdgcn_readfirstlane(tid >> 6);
    const int G = gridDim.x, bx = blockIdx.x;
    if (tid < 2) ((volatile LAS unsigned*)(lds + MISC_OFF))[tid] = 0u;
    __syncthreads();
    const XcdBarrier xbar = xcd_barrier_post((unsigned*)(a.ws + WS_CTL), (volatile LAS unsigned*)(lds + MISC_OFF));
#define GRID_SEAM() do { if (a.use_cg) grid.sync(); else xcd_barrier(xbar); } while (0)
    const int vcu = (G % 8 == 0) ? (bx % 8) * (G / 8) + bx / 8 : bx;
    unsigned char* ws = a.ws;
    const float* x = a.in[0];
    bf16_t* WinT = (bf16_t*)(ws + WS_WIN); bf16_t* WgluT = (bf16_t*)(ws + WS_WGLU); bf16_t* WaoT = (bf16_t*)(ws + WS_WAO);
    bf16_t* WsoT = (bf16_t*)(ws + WS_WSO); bf16_t* WoutT = (bf16_t*)(ws + WS_WOUT);
    float* SSQ = (float*)(ws + WS_SSQ);
    bf16_t* XN = (bf16_t*)(ws + WS_XN);
    bf16_t* PROJ = (bf16_t*)(ws + WS_PROJ);

    {
        LAS float* scr = (LAS float*)(lds + wave * 16384);
        const int gw = bx * NWAVES + wave, NGW = G * NWAVES;
        constexpr int I_IN = (DM / 64) * (NIN / 32), I_GLU = (512 / 64) * (1024 / 32), I_AO = I_GLU, I_SO = I_GLU, I_OUT = (DM / 64) * (DM / 32);
        constexpr int NITEMS = I_IN + I_GLU + I_AO + I_SO + I_OUT;
        for (int it = gw; it < NITEMS; it += NGW) {
            int r = it;
            if (r < I_IN) { p0_transpose_item(a.in[2], DM, NIN, WinT, false, scr, r, lane); continue; } r -= I_IN;
            if (r < I_GLU) { p0_transpose_item(a.in[12], 512, 1024, WgluT, true, scr, r, lane); continue; } r -= I_GLU;
            if (r < I_AO) { p0_transpose_item(a.in[14], 512, 1024, WaoT, false, scr, r, lane); continue; } r -= I_AO;
            if (r < I_SO) { p0_transpose_item(a.in[15], 512, 1024, WsoT, false, scr, r, lane); continue; } r -= I_SO;
            p0_transpose_item(a.in[17], DM, DM, WoutT, false, scr, r, lane);
        }
        const float* gain = a.in[1];
        f32x4 gv[4];
#pragma unroll
        for (int j = 0; j < 4; ++j) gv[j] = *(const f32x4*)(gain + 4 * lane + 256 * j);
        for (int m = gw; m < M_TOK; m += 2 * NGW) {
            const int m1 = m + NGW; const bool two = m1 < M_TOK;
            const f32x4* xr0 = (const f32x4*)(x + (size_t)m * DM) + lane; const f32x4* xr1 = (const f32x4*)(x + (size_t)(two ? m1 : m) * DM) + lane;
            f32x4 v[4], w4[4]; float s = 0.f, s1 = 0.f;
#pragma unroll
            for (int j = 0; j < 4; ++j) { v[j] = xr0[64 * j]; w4[j] = xr1[64 * j]; }
#pragma unroll
            for (int j = 0; j < 4; ++j) { s += (v[j][0] * v[j][0] + v[j][1] * v[j][1]) + (v[j][2] * v[j][2] + v[j][3] * v[j][3]); s1 += (w4[j][0] * w4[j][0] + w4[j][1] * w4[j][1]) + (w4[j][2] * w4[j][2] + w4[j][3] * w4[j][3]); }
            const float inv = 1.0f / sqrtf(wave_sum(s) * (1.f / DM) + NORM_EPS), inv1 = 1.0f / sqrtf(wave_sum(s1) * (1.f / DM) + NORM_EPS);
            u32x2* o8 = (u32x2*)(XN + (size_t)m * DM) + lane;
#pragma unroll
            for (int j = 0; j < 4; ++j) { u32x2 w; w.x = cvtpk(v[j][0] * inv * gv[j][0], v[j][1] * inv * gv[j][1]); w.y = cvtpk(v[j][2] * inv * gv[j][2], v[j][3] * inv * gv[j][3]); o8[64 * j] = w; }
            if (two) { u32x2* o9 = (u32x2*)(XN + (size_t)m1 * DM) + lane;
#pragma unroll
                for (int j = 0; j < 4; ++j) { u32x2 w; w.x = cvtpk(w4[j][0] * inv1 * gv[j][0], w4[j][1] * inv1 * gv[j][1]); w.y = cvtpk(w4[j][2] * inv1 * gv[j][2], w4[j][3] * inv1 * gv[j][3]); o9[64 * j] = w; } }
        }
    }
    GRID_SEAM();

    {
        pg8::Gemm g{XN, XN, WinT, WinT, DM, DM}; pg8::StaticOrder S; S.init(M_TOK, NIN, G, bx, 1);
        pg8::EpiProj E{PROJ, a.in[16]};
        pg8::gemm_phase<pg8::EpiProj>(lds, g, S, E);
    }
    GRID_SEAM();

    {
        SsmIn si{a.in[4], a.in[5], a.in[6], a.in[7], a.in[8], a.in[9], a.in[10], a.in[11]};
        for (int sidx = vcu; sidx < NBATCH * 32; sidx += G) ssm_unit(sidx >> 5, sidx & 31, PROJ, si, lds, wave, lane);
        LAS unsigned char* wl = lds + wave * ATT_WAVE_LDS;
        attn_build_table(a.in[3], wave, wl, lane);
        const int NU = NBATCH * 64, per = (NU + G - 1) / G;
        for (int i = 0; i < per; ++i) { const int uidx = vcu * per + i; if (uidx < NU) attn_unit(uidx >> 6, uidx & 63, wave, PROJ, wl, lane); }
    }
    GRID_SEAM();

    {
        pg8::Gemm g{PROJ + C_U, PROJ + C_U, WgluT, WgluT, NIN, 512}; pg8::StaticOrder S; S.init(M_TOK, 1024, G, bx, 1);
        pg8::EpiGlu E{PROJ, a.in[13]};
        pg8::gemm_phase<pg8::EpiGlu>(lds, g, S, E);
    }
    GRID_SEAM();

    {
        pg8::Gemm g{PROJ + C_Q, PROJ + C_ZS, WaoT, WsoT, NIN, 512}; pg8::StaticOrder S; S.init(M_TOK, DM, G, bx, 2);
        pg8::EpiMerge E{PROJ, a.out, XN};
        pg8::gemm_phase<pg8::EpiMerge>(lds, g, S, E);
    }
    GRID_SEAM();

    {
        pg8::Gemm g{XN, XN, WoutT, WoutT, DM, DM}; pg8::StaticOrder S; S.init(M_TOK, DM, G, bx, 1);
        pg8::EpiOut E{x, a.out, SSQ};
        pg8::gemm_phase<pg8::EpiOut>(lds, g, S, E);
    }
    GRID_SEAM();

    {
        const int gw = bx * NWAVES + wave, NGW = G * NWAVES;
        const float* gain = a.in[18];
        f32x4 gv[4];
#pragma unroll
        for (int j = 0; j < 4; ++j) gv[j] = *(const f32x4*)(gain + 4 * lane + 256 * j);
        for (int m = gw; m < M_TOK; m += 2 * NGW) {
            const int m1 = m + NGW; const bool two = m1 < M_TOK; const int mb = two ? m1 : m;
            const f32x4* sp = (const f32x4*)(SSQ + (size_t)m * 16); const f32x4* sq = (const f32x4*)(SSQ + (size_t)mb * 16);
            const f32x4 s0 = sp[0], s1 = sp[1], s2 = sp[2], s3 = sp[3], t0 = sq[0], t1 = sq[1], t2 = sq[2], t3 = sq[3];
            f32x4* orow = (f32x4*)(a.out + (size_t)m * DM) + lane; f32x4* orow1 = (f32x4*)(a.out + (size_t)mb * DM) + lane;
            f32x4 v[4], w4[4];
#pragma unroll
            for (int j = 0; j < 4; ++j) { v[j] = orow[64 * j]; w4[j] = orow1[64 * j]; }
            const float ss = ((s0[0] + s0[1]) + (s0[2] + s0[3])) + ((s1[0] + s1[1]) + (s1[2] + s1[3])) + ((s2[0] + s2[1]) + (s2[2] + s2[3])) + ((s3[0] + s3[1]) + (s3[2] + s3[3]));
            const float st = ((t0[0] + t0[1]) + (t0[2] + t0[3])) + ((t1[0] + t1[1]) + (t1[2] + t1[3])) + ((t2[0] + t2[1]) + (t2[2] + t2[3])) + ((t3[0] + t3[1]) + (t3[2] + t3[3]));
            const float inv = 1.0f / sqrtf(ss * (1.f / DM) + NORM_EPS), inv1 = 1.0f / sqrtf(st * (1.f / DM) + NORM_EPS);
#pragma unroll
            for (int j = 0; j < 4; ++j) orow[64 * j] = v[j] * inv * gv[j];
            if (two) {
#pragma unroll
                for (int j = 0; j < 4; ++j) orow1[64 * j] = w4[j] * inv1 * gv[j]; }
        }
    }
}

extern "C" void kernel_launch(void* const* d_in, const int* in_sizes, int n_in, void* d_out, int out_size, void* d_ws, size_t ws_size, hipStream_t stream) {
    static int grid = 0;
    if (grid == 0) {
        if (n_in != 19 || in_sizes[0] != M_TOK * DM || out_size != M_TOK * DM || ws_size < WS_END) { fprintf(stderr, "kernel_launch: unexpected shapes (n_in %d, ws %zu)\n", n_in, ws_size); grid = -1; return; }
        int dev = 0, cus = 0, per_cu = 0;
        hipGetDevice(&dev);
        hipDeviceGetAttribute(&cus, hipDeviceAttributeMultiprocessorCount, dev);
        hipFuncSetAttribute((const void*)fwd_megakernel, hipFuncAttributeMaxDynamicSharedMemorySize, LDS_BYTES);
        hipOccupancyMaxActiveBlocksPerMultiprocessor(&per_cu, (const void*)fwd_megakernel, NWAVES * 64, LDS_BYTES);
        if (per_cu < 1) per_cu = 1;
        grid = cus * per_cu;
        (void)hipGetLastError();
    }
    if (grid < 0) return;
    Args a{};
    for (int i = 0; i < 19; ++i) a.in[i] = (const float*)d_in[i];
    a.out = (float*)d_out; a.ws = (unsigned char*)d_ws; a.use_cg = 0; a.pad = 0;
    if (hipMemsetAsync((char*)d_ws + WS_CTL, 0, CTL_ZERO_BYTES, stream) != hipSuccess) { fprintf(stderr, "kernel_launch: memset failed\n"); return; }
    void* args[] = {&a};
    hipError_t e = hipLaunchCooperativeKernel((const void*)fwd_megakernel, dim3(grid), dim3(NWAVES * 64), args, LDS_BYTES, stream);
    if (e != hipSuccess) fprintf(stderr, "cooperative launch failed: %s (grid %d)\n", hipGetErrorString(e), grid);
}
```

```cpp
#include <hip/hip_runtime.h>
#include <hip/hip_cooperative_groups.h>
#include <cstdio>
#include <cstdint>
namespace cg = cooperative_groups;

#define LAS __attribute__((address_space(3)))
typedef unsigned short bf16_t;
typedef short bf16x8 __attribute__((ext_vector_type(8)));
typedef short s16x4 __attribute__((ext_vector_type(4)));
typedef float f32x2 __attribute__((ext_vector_type(2)));
typedef float f32x4 __attribute__((ext_vector_type(4)));
typedef float f32x16 __attribute__((ext_vector_type(16)));
typedef unsigned u32x2 __attribute__((ext_vector_type(2)));
typedef unsigned u32x4 __attribute__((ext_vector_type(4)));
typedef __bf16 bf16x2_t __attribute__((ext_vector_type(2)));

constexpr int M_TOK = 32768, DM = 1024, NIN = 5120, SEQ = 4096, NBATCH = 8;
constexpr int C_Q = 0, C_K = 512, C_V = 1024, C_ZA = 1536, C_U = 2048, C_ZS = 2560, C_GA = 3072, C_GS = 4096;
constexpr float NORM_EPS = 1e-6f;
constexpr float LOG2E = 1.4426950408889634f;
constexpr size_t MiB = 1u << 20;
constexpr size_t WS_WIN = 0, WS_WGLU = 10 * MiB, WS_WAO = 11 * MiB, WS_WSO = 12 * MiB, WS_WOUT = 13 * MiB, WS_SSQ = 15 * MiB;
constexpr size_t WS_CTL = 17 * MiB, CTL_ZERO_BYTES = 98304, CTL_CNT_OFF = 16384, CTL_G3_OFF = 49152, CTL_G4_OFF = 65536;
constexpr size_t WS_XN = 32 * MiB;
constexpr size_t WS_PROJ = 96 * MiB;
constexpr size_t WS_END = 416 * MiB;
constexpr int LDS_BYTES = 147456;
constexpr int NWAVES = 8;
#ifndef PROBE_A
#define PROBE_A (-1)
#define PROBE_B (-1)
#endif
constexpr int MISC_OFF = 131072 + 64;

__device__ __forceinline__ unsigned cvtpk(float lo, float hi) { f32x2 v = {lo, hi}; bf16x2_t b = __builtin_convertvector(v, bf16x2_t); return __builtin_bit_cast(unsigned, b); }
__device__ __forceinline__ float bflo(unsigned w) { return __uint_as_float(w << 16); }
__device__ __forceinline__ float bfhi(unsigned w) { return __uint_as_float(w & 0xffff0000u); }
__device__ __forceinline__ float sigm(float x) { return __builtin_amdgcn_rcpf(1.f + __builtin_amdgcn_exp2f(-LOG2E * x)); }
__device__ __forceinline__ float silu_f(float x) { return x * sigm(x); }
__device__ __forceinline__ float gelu_tanh_f(float x) { return x * sigm(1.5957691216057308f * (x + 0.044715f * x * x * x)); }
__device__ __forceinline__ float wave_sum(float v) {
#pragma unroll
    for (int o = 1; o < 64; o <<= 1) v += __shfl_xor(v, o);
    return v;
}

namespace pg8 {
constexpr int BM = 256, BK = 64, HALF = 128, HTB = HALF * BK * 2, STAGE_BYTES = 8 * HTB, NXCD = 8, WGM = 8;
__host__ __device__ __forceinline__ int lds_byte(int r, int c) { const int st = (r >> 4) * 2 + (c >> 5), rr = r & 15, cc = c & 31, ob = rr * 64 + cc * 2; return st * 1024 + (ob ^ (((ob >> 9) & 1) << 5)); }
__host__ __device__ __forceinline__ void stage_rc(int b, int& R, int& C) { const int st = b / 1024, sb = b % 1024, swz = sb ^ (((sb >> 9) & 1) << 5); R = (st >> 1) * 16 + swz / 64; C = (st & 1) * 32 + (swz % 64) / 2; }
__host__ __device__ __forceinline__ int perm32(int rho) { const int n = rho >> 4, i = rho & 15; return 8 * (i >> 2) + 4 * n + (i & 3); }

struct Unit { int pm, pn, z; };
__device__ __forceinline__ void st16_wt(void* p, u32x4 v) { asm volatile("global_store_dwordx4 %0, %1, off sc1\n\ts_nop 0" :: "v"(p), "v"(v) : "memory");     }
struct Gemm { const bf16_t* A0; const bf16_t* A1; const bf16_t* B0; const bf16_t* B1; int lda, K; };

struct StaticOrder {
    int nM, nN, nwg, G, c, nz;
    __device__ void init(int M, int N, int G_, int c_, int nz_) { nM = M / BM; nN = N / BM; nwg = nM * nN; G = G_; c = c_; nz = nz_; }
    __device__ bool next(int i, Unit& u) const {
        const int ti = (nz == 2) ? (i >> 1) : i; u.z = (nz == 2) ? (i & 1) : 0;
        const long L = (long)ti * G + c; if (L >= nwg) return false;
        int wgid = (int)L; { const int q = nwg / NXCD, r = nwg % NXCD, xcd = wgid % NXCD, off = wgid / NXCD; wgid = (xcd < r ? xcd * (q + 1) : r * (q + 1) + (xcd - r) * q) + off; }
        const int nig = WGM * nN, gid = wgid / nig, fm = gid * WGM, gsz = (nM - fm) < WGM ? (nM - fm) : WGM;
        u.pm = fm + ((wgid % nig) % gsz); u.pn = (wgid % nig) / gsz; return true;
    }
};

template <class Epi>
__device__ __forceinline__ void gemm_phase(LAS unsigned char* lds, const Gemm g, const StaticOrder& S, const Epi& E) {
    int tid = threadIdx.x; asm volatile("" : "+v"(tid));
    const int wid = __builtin_amdgcn_readfirstlane(tid >> 6), lane = tid & 63, wr = wid >> 2, wc = wid & 3, fr = lane & 15, fq = lane >> 4;
    const int K = g.K, nt = K / BK, lda = g.lda;
    unsigned voffA[2], voffB[2];
#pragma unroll
    for (int i = 0; i < 2; ++i) { int R, C; stage_rc(tid * 16 + i * 8192, R, C); const int Rb = (R & ~31) + perm32(R & 31);
        voffA[i] = (unsigned)(R * lda + C) * 2u; voffB[i] = (unsigned)(Rb * K + C) * 2u; }
    const size_t kstep = (size_t)(BK * 2);
    const size_t hstepA = (size_t)HALF * lda * 2, tstepA = 2 * hstepA;
    const size_t hstepB = (size_t)HALF * K * 2, tstepB = 2 * hstepB;
    const unsigned ldsw = (unsigned)wid * 1024u;
    const int aoff = lds_byte(wr * 64 + fr, fq * 8), boff = lds_byte(wc * 32 + fr, fq * 8);
#define PG8_SA(b, h) (((b) * 2 + (h)) * HTB)
#define PG8_SB(b, h) ((4 + (b) * 2 + (h)) * HTB)
#define PG8_STAGE(bufoff, gbase, voff) do { _Pragma("unroll") for (int _i = 0; _i < 2; ++_i) \
        __builtin_amdgcn_global_load_lds((const unsigned*)((const char*)(gbase) + (voff)[_i]), (LAS unsigned*)(lds + (bufoff) + ldsw + _i * 8192), 16, 0, 0); } while (0)
#define PG8_LDA(dst, b, h) do { _Pragma("unroll") for (int m = 0; m < 4; ++m) _Pragma("unroll") for (int k = 0; k < 2; ++k) dst[m][k] = *(const LAS bf16x8*)(lds + PG8_SA(b, h) + aoff + m * 2048 + k * 1024); } while (0)
#define PG8_LDB(dst, b, h) do { _Pragma("unroll") for (int n = 0; n < 2; ++n) _Pragma("unroll") for (int k = 0; k < 2; ++k) dst[n][k] = *(const LAS bf16x8*)(lds + PG8_SB(b, h) + boff + n * 2048 + k * 1024); } while (0)
#define PG8_MMA(ai, bj, At, Bt) do { __builtin_amdgcn_s_setprio(1); _Pragma("unroll") for (int m = 0; m < 4; ++m) _Pragma("unroll") for (int n = 0; n < 2; ++n) _Pragma("unroll") for (int k = 0; k < 2; ++k) \
        acc[ai][bj][m][n] = __builtin_amdgcn_mfma_f32_16x16x32_bf16(Bt[n][k], At[m][k], acc[ai][bj][m][n], 0, 0, 0); __builtin_amdgcn_s_setprio(0); } while (0)
#define PG8_WAIT_V(n) asm volatile("s_waitcnt vmcnt(" #n ")" ::: "memory")
#define PG8_WAIT_L(n) asm volatile("s_waitcnt lgkmcnt(" #n ")" ::: "memory")
#define PG8_BAR __builtin_amdgcn_s_barrier()
#define PG8_SCHED __builtin_amdgcn_sched_barrier(0)
    Unit cur, nxt; int ui = 0;
    if (!S.next(0, cur)) return;
    f32x4 acc[2][2][4][2];
#pragma unroll
    for (int a = 0; a < 2; ++a)
#pragma unroll
        for (int b = 0; b < 2; ++b)
#pragma unroll
            for (int m = 0; m < 4; ++m)
#pragma unroll
                for (int n = 0; n < 2; ++n) acc[a][b][m][n] = (f32x4){0.f, 0.f, 0.f, 0.f};
    bf16x8 At[4][2], B0[2][2], B1[2][2];
    const char* cA = (const char*)(cur.z ? g.A1 : g.A0) + (size_t)cur.pm * tstepA; const char* cB = (const char*)(cur.z ? g.B1 : g.B0) + (size_t)cur.pn * tstepB;
    PG8_STAGE(PG8_SB(0, 0), cB, voffB); PG8_STAGE(PG8_SB(0, 1), cB + hstepB, voffB); PG8_STAGE(PG8_SA(0, 0), cA, voffA); PG8_STAGE(PG8_SA(0, 1), cA + hstepA, voffA);
    if (wr == 1) PG8_BAR;
    PG8_WAIT_V(2); PG8_BAR;
    PG8_STAGE(PG8_SB(1, 0), cB + kstep, voffB); PG8_STAGE(PG8_SA(1, 0), cA + kstep, voffA); PG8_STAGE(PG8_SB(1, 1), cB + hstepB + kstep, voffB);
    PG8_WAIT_V(6); PG8_BAR;
    for (;;) {
        const bool has_next = S.next(ui + 1, nxt);
        const char* nA = has_next ? (const char*)(nxt.z ? g.A1 : g.A0) + (size_t)nxt.pm * tstepA : cA; const char* nB = has_next ? (const char*)(nxt.z ? g.B1 : g.B0) + (size_t)nxt.pn * tstepB : cB;
        for (int t = 0; t < nt; t += 2) {
            const bool last = (t == nt - 2);
            const char* a1 = cA + (size_t)(t + 1) * kstep;
            const char* a2 = last ? nA : cA + (size_t)(t + 2) * kstep; const char* b2 = last ? nB : cB + (size_t)(t + 2) * kstep;
            const char* a3 = a2 + kstep; const char* b3 = b2 + kstep;
            PG8_LDB(B0, 0, 0); PG8_LDB(B1, 0, 1); PG8_SCHED; PG8_LDA(At, 0, 0); PG8_STAGE(PG8_SA(1, 1), a1 + hstepA, voffA);
            PG8_WAIT_V(8); PG8_WAIT_L(0); PG8_BAR; PG8_MMA(0, 0, At, B0); PG8_MMA(0, 1, At, B1); PG8_BAR; PG8_SCHED;
            PG8_LDA(At, 0, 1); PG8_STAGE(PG8_SB(0, 0), b2, voffB); PG8_STAGE(PG8_SB(0, 1), b2 + hstepB, voffB); PG8_STAGE(PG8_SA(0, 0), a2, voffA);
            PG8_WAIT_V(8); PG8_WAIT_L(0); PG8_BAR; PG8_MMA(1, 0, At, B0); PG8_MMA(1, 1, At, B1); PG8_BAR; PG8_SCHED;
            PG8_LDB(B0, 1, 0); PG8_LDB(B1, 1, 1); PG8_SCHED; PG8_LDA(At, 1, 0); PG8_STAGE(PG8_SA(0, 1), a2 + hstepA, voffA);
            PG8_WAIT_V(8); PG8_WAIT_L(0); PG8_BAR; PG8_MMA(0, 0, At, B0); PG8_MMA(0, 1, At, B1); PG8_BAR; PG8_SCHED;
            PG8_LDA(At, 1, 1); PG8_STAGE(PG8_SB(1, 0), b3, voffB); PG8_STAGE(PG8_SB(1, 1), b3 + hstepB, voffB); PG8_STAGE(PG8_SA(1, 0), a3, voffA);
            PG8_WAIT_V(8); PG8_WAIT_L(0); PG8_BAR; PG8_MMA(1, 0, At, B0); PG8_MMA(1, 1, At, B1); PG8_BAR; PG8_SCHED;
        }
        if (wr == 0) PG8_BAR;
        E(acc, cur, wr, wc, fr, fq);
        if (!has_next) break;
        if (!(Epi::CHAIN_Z && cur.z == 0)) {
#pragma unroll
        for (int a = 0; a < 2; ++a)
#pragma unroll
            for (int b = 0; b < 2; ++b)
#pragma unroll
                for (int m = 0; m < 4; ++m)
#pragma unroll
                    for (int n = 0; n < 2; ++n) acc[a][b][m][n] = (f32x4){0.f, 0.f, 0.f, 0.f};
        }
        cur = nxt; cA = nA; cB = nB; ++ui;
        if (wr == 1) PG8_BAR;
    }
    PG8_WAIT_V(0);
    PG8_BAR;
#undef PG8_SA
#undef PG8_SB
#undef PG8_STAGE
#undef PG8_LDA
#undef PG8_LDB
#undef PG8_MMA
#undef PG8_WAIT_V
#undef PG8_WAIT_L
#undef PG8_BAR
#undef PG8_SCHED
}

struct EpiProj {
    static constexpr bool CHAIN_Z = false;
    bf16_t* O; const float* gate_bias;
    __device__ __forceinline__ void operator()(f32x4 (&acc)[2][2][4][2], const Unit& u, int wr, int wc, int fr, int fq) const {
        const int pn = u.pn;
        const int mode = (pn < 2) ? 1 : (pn < 6) ? 0 : (pn < 8) ? 2 : (pn < 10) ? 0 : (pn < 12) ? 2 : 3;
        const int row0 = u.pm * BM + wr * 64 + fr, col0 = pn * BM + wc * 32 + 8 * fq;
        if (mode == 3) {
            const int j0 = (pn - 12) * HALF + wc * 32 + 8 * fq;
            f32x4 ba[2], bb[2];
#pragma unroll
            for (int n = 0; n < 2; ++n) { ba[n] = *(const f32x4*)(gate_bias + j0 + 4 * n); bb[n] = *(const f32x4*)(gate_bias + 1024 + j0 + 4 * n); }
#pragma unroll
            for (int ai = 0; ai < 2; ++ai)
#pragma unroll
                for (int m = 0; m < 4; ++m) { bf16_t* rowp = O + (size_t)(row0 + ai * HALF + m * 16) * NIN + col0; float rho[8], gs[8];
#pragma unroll
                    for (int n = 0; n < 2; ++n) { const f32x4 a = acc[ai][0][m][n] + ba[n], b = acc[ai][1][m][n] + bb[n];
#pragma unroll
                        for (int i = 0; i < 4; ++i) { const float ea = __builtin_amdgcn_exp2f(-LOG2E * a[i]), eb = __builtin_amdgcn_exp2f(-LOG2E * fmaxf(b[i], -40.f));
                            const float ia = __builtin_amdgcn_rcpf(1.f + ea); rho[4 * n + i] = (1.f + eb) * ia; gs[4 * n + i] = __builtin_amdgcn_rcpf(1.f + eb); } }
                    u32x4 w; w.x = cvtpk(rho[0], rho[1]); w.y = cvtpk(rho[2], rho[3]); w.z = cvtpk(rho[4], rho[5]); w.w = cvtpk(rho[6], rho[7]);
                    *(u32x4*)rowp = w;
                    w.x = cvtpk(gs[0], gs[1]); w.y = cvtpk(gs[2], gs[3]); w.z = cvtpk(gs[4], gs[5]); w.w = cvtpk(gs[6], gs[7]);
                    *(u32x4*)(rowp + HALF) = w; }
            return;
        }
#pragma unroll
        for (int ai = 0; ai < 2; ++ai)
#pragma unroll
            for (int m = 0; m < 4; ++m) { bf16_t* rowp = O + (size_t)(row0 + ai * HALF + m * 16) * NIN + col0;
#pragma unroll
                for (int bj = 0; bj < 2; ++bj) { f32x4 v0 = acc[ai][bj][m][0], v1 = acc[ai][bj][m][1];
                    if (mode == 1) { v0 = v0 * (0.125f * LOG2E); v1 = v1 * (0.125f * LOG2E); }
                    else if (mode == 2) {
#pragma unroll
                        for (int i = 0; i < 4; ++i) { v0[i] = silu_f(v0[i]); v1[i] = silu_f(v1[i]); } }
                    u32x4 w; w.x = cvtpk(v0[0], v0[1]); w.y = cvtpk(v0[2], v0[3]); w.z = cvtpk(v1[0], v1[1]); w.w = cvtpk(v1[2], v1[3]);
                    *(u32x4*)(rowp + bj * HALF) = w; } }
    }
};
struct EpiGlu {
    static constexpr bool CHAIN_Z = false;
    bf16_t* P; const float* b_glu;
    __device__ __forceinline__ void operator()(f32x4 (&acc)[2][2][4][2], const Unit& u, int wr, int wc, int fr, int fq) const {
        const int row0 = u.pm * BM + wr * 64 + fr, j0 = u.pn * HALF + wc * 32 + 8 * fq;
        f32x4 ba[2], bb[2];
#pragma unroll
        for (int n = 0; n < 2; ++n) { ba[n] = *(const f32x4*)(b_glu + j0 + 4 * n); bb[n] = *(const f32x4*)(b_glu + 512 + j0 + 4 * n); }
#pragma unroll
        for (int ai = 0; ai < 2; ++ai)
#pragma unroll
            for (int m = 0; m < 4; ++m) { bf16_t* zp = P + (size_t)(row0 + ai * HALF + m * 16) * NIN + C_ZS + j0;
                const u32x4 z = *(const u32x4*)zp; float r[8];
#pragma unroll
                for (int n = 0; n < 2; ++n) { const f32x4 a = acc[ai][0][m][n] + ba[n], b = acc[ai][1][m][n] + bb[n];
#pragma unroll
                    for (int i = 0; i < 4; ++i) r[4 * n + i] = a[i] * sigm(b[i]); }
                u32x4 w; w.x = cvtpk(r[0] * bflo(z.x), r[1] * bfhi(z.x)); w.y = cvtpk(r[2] * bflo(z.y), r[3] * bfhi(z.y));
                w.z = cvtpk(r[4] * bflo(z.z), r[5] * bfhi(z.z)); w.w = cvtpk(r[6] * bflo(z.w), r[7] * bfhi(z.w));
                st16_wt(zp, w); }
    }
};
struct EpiMerge {
    static constexpr bool CHAIN_Z = true;
    const bf16_t* P; bf16_t* MG;
    __device__ __forceinline__ void operator()(f32x4 (&acc)[2][2][4][2], const Unit& u, int wr, int wc, int fr, int fq) const {
        const int row0 = u.pm * BM + wr * 64 + fr, col0 = u.pn * BM + wc * 32 + 8 * fq;
        const int gcol0 = C_GA + 256 * (2 * u.pn) + (u.z ? HALF : 0) + wc * 32 + 8 * fq;
#pragma unroll
        for (int ai = 0; ai < 2; ++ai) {
            u32x4 gt[4][2];
#pragma unroll
            for (int m = 0; m < 4; ++m)
#pragma unroll
                for (int bj = 0; bj < 2; ++bj) gt[m][bj] = *(const u32x4*)(P + (size_t)(row0 + ai * HALF + m * 16) * NIN + gcol0 + 256 * bj);
#pragma unroll
            for (int m = 0; m < 4; ++m)
#pragma unroll
                for (int bj = 0; bj < 2; ++bj) { const u32x4 g4 = gt[m][bj];
                    f32x4 v0 = acc[ai][bj][m][0], v1 = acc[ai][bj][m][1];
                    v0[0] *= bflo(g4.x); v0[1] *= bfhi(g4.x); v0[2] *= bflo(g4.y); v0[3] *= bfhi(g4.y);
                    v1[0] *= bflo(g4.z); v1[1] *= bfhi(g4.z); v1[2] *= bflo(g4.w); v1[3] *= bfhi(g4.w);
                    if (u.z == 0) { acc[ai][bj][m][0] = v0; acc[ai][bj][m][1] = v1; }
                    else { u32x4 w; w.x = cvtpk(v0[0], v0[1]); w.y = cvtpk(v0[2], v0[3]); w.z = cvtpk(v1[0], v1[1]); w.w = cvtpk(v1[2], v1[3]);
                        st16_wt(MG + (size_t)(row0 + ai * HALF + m * 16) * DM + col0 + bj * HALF, w); } }
        }
    }
};
constexpr int EX_OFF = 131072 + 1024;
struct EpiOutNorm {
    static constexpr bool CHAIN_Z = false;
    const float* x; float* out; const float* gain; float* xbuf; unsigned* cnt; LAS unsigned char* lds;
    __device__ __forceinline__ void operator()(f32x4 (&acc)[2][2][4][2], const Unit& u, int wr, int wc, int fr, int fq) const {
        const int tid = threadIdx.x, wid = tid >> 6, lane = tid & 63;
        LAS float* P = (LAS float*)(lds + EX_OFF);
        LAS float* S = (LAS float*)(lds + EX_OFF + 4096);
        const int row0 = u.pm * BM + wr * 64 + fr, col0 = u.pn * BM + wc * 32 + 8 * fq;
#pragma unroll
        for (int ai = 0; ai < 2; ++ai)
#pragma unroll
            for (int m = 0; m < 4; ++m) { const size_t row = (size_t)(row0 + ai * HALF + m * 16); float s = 0.f;
#pragma unroll
                for (int bj = 0; bj < 2; ++bj) { const size_t o = row * DM + col0 + bj * HALF;
                    const f32x4 v0 = acc[ai][bj][m][0] + *(const f32x4*)(x + o), v1 = acc[ai][bj][m][1] + *(const f32x4*)(x + o + 4);
                    acc[ai][bj][m][0] = v0; acc[ai][bj][m][1] = v1;
                    s += (v0[0] * v0[0] + v0[1] * v0[1]) + (v0[2] * v0[2] + v0[3] * v0[3]) + (v1[0] * v1[0] + v1[1] * v1[1]) + (v1[2] * v1[2] + v1[3] * v1[3]); }
                s += __shfl_xor(s, 16); s += __shfl_xor(s, 32);
                if (fq == 0) P[(ai * HALF + wr * 64 + m * 16 + fr) * 4 + wc] = s; }
        asm volatile("s_waitcnt lgkmcnt(0)" ::: "memory"); __builtin_amdgcn_s_barrier(); asm volatile("" ::: "memory");
        const int prow = wid * 32 + (lane & 31);
        if (lane < 32) { const float t = (P[prow * 4 + 0] + P[prow * 4 + 1]) + (P[prow * 4 + 2] + P[prow * 4 + 3]);
            __hip_atomic_store(xbuf + ((size_t)(u.pm * BM + prow) * 4 + u.pn), t, __ATOMIC_RELAXED, __HIP_MEMORY_SCOPE_AGENT); }
        asm volatile("s_waitcnt vmcnt(0)" ::: "memory");
        if (lane == 0) __hip_atomic_fetch_add(cnt + 64 * u.pm, 1u, __ATOMIC_RELAXED, __HIP_MEMORY_SCOPE_AGENT);
        if (wid == 0) { unsigned sp = 0;
            while ((unsigned)__builtin_amdgcn_readfirstlane(__hip_atomic_load(cnt + 64 * u.pm, __ATOMIC_RELAXED, __HIP_MEMORY_SCOPE_AGENT)) < 32u) { __builtin_amdgcn_s_sleep(2); if (++sp > (1u << 22)) break; }
            __builtin_amdgcn_fence(__ATOMIC_ACQUIRE, "agent"); }
        asm volatile("s_waitcnt vmcnt(0) lgkmcnt(0)" ::: "memory"); __builtin_amdgcn_s_barrier(); asm volatile("" ::: "memory");
        if (lane < 32) { const float* sl = xbuf + (size_t)(u.pm * BM + prow) * 4; float q = 0.f;
#pragma unroll
            for (int t = 0; t < 4; ++t) q += __hip_atomic_load(sl + t, __ATOMIC_RELAXED, __HIP_MEMORY_SCOPE_AGENT);
            S[prow] = 1.0f / sqrtf(q * (1.f / DM) + NORM_EPS); }
        asm volatile("s_waitcnt lgkmcnt(0)" ::: "memory"); __builtin_amdgcn_s_barrier(); asm volatile("" ::: "memory");
        f32x4 gv[2][2];
#pragma unroll
        for (int bj = 0; bj < 2; ++bj)
#pragma unroll
            for (int n = 0; n < 2; ++n) gv[bj][n] = *(const f32x4*)(gain + col0 + bj * HALF + 4 * n);
#pragma unroll
        for (int ai = 0; ai < 2; ++ai)
#pragma unroll
            for (int m = 0; m < 4; ++m) { const int r = ai * HALF + wr * 64 + m * 16 + fr; const float inv = S[r]; const size_t row = (size_t)(u.pm * BM + r);
#pragma unroll
                for (int bj = 0; bj < 2; ++bj) { const size_t o = row * DM + col0 + bj * HALF;
                    *(f32x4*)(out + o) = acc[ai][bj][m][0] * inv * gv[bj][0]; *(f32x4*)(out + o + 4) = acc[ai][bj][m][1] * inv * gv[bj][1]; } }
        asm volatile("s_waitcnt lgkmcnt(0)" ::: "memory"); __builtin_amdgcn_s_barrier(); asm volatile("" ::: "memory");
    }
};
}

__device__ __forceinline__ void p0_transpose_item(const float* W, int K, int N, bf16_t* WT, int map, LAS float* scr, int item, int lane) {
    const int nblk = N / 32, kb = item / nblk, nb = item % nblk, k0 = 64 * kb, n0 = 32 * nb;
    int r0 = n0;
    if (map == 1) { const int bj = n0 >> 9, rem = n0 & 511, pn = rem >> 7, w = rem & 127; r0 = 256 * pn + 128 * bj + w; }
    if (map == 2 && n0 >= C_GA) { const int j0 = (n0 - C_GA) & 1023, isS = (n0 - C_GA) >> 10; r0 = C_GA + 256 * (j0 >> 7) + 128 * isS + (j0 & 127); }
#pragma unroll 8
    for (int i = 0; i < 32; ++i) { const int kk = 2 * i + (lane >> 5); scr[kk * 33 + (lane & 31)] = __builtin_nontemporal_load(&W[(size_t)(k0 + kk) * N + n0 + (lane & 31)]); }
    asm volatile("s_waitcnt lgkmcnt(0)" ::: "memory");
    const int c = lane & 7;
#pragma unroll
    for (int j = 0; j < 4; ++j) { const int n = (lane >> 3) + 8 * j; const LAS float* s = scr + (8 * c) * 33 + n;
        u32x4 o; o.x = cvtpk(s[0 * 33], s[1 * 33]); o.y = cvtpk(s[2 * 33], s[3 * 33]); o.z = cvtpk(s[4 * 33], s[5 * 33]); o.w = cvtpk(s[6 * 33], s[7 * 33]);
        *(u32x4*)(WT + (size_t)(r0 + n) * K + k0 + 8 * c) = o; }
    asm volatile("s_waitcnt lgkmcnt(0)" ::: "memory");
}

__device__ __forceinline__ void sincos_acc(float th, float& s, float& c) {
    const float k = rintf(th * 0.636619772f);
    float r = fmaf(-k, 1.57079637050628662109375f, th); r = fmaf(-k, -4.371139000186241e-08f, r);
    const int q = ((int)k) & 3; const float r2 = r * r;
    const float sp = r * (1.f + r2 * (-1.66666667e-1f + r2 * (8.33333333e-3f + r2 * (-1.98412698e-4f + r2 * 2.75573192e-6f))));
    const float cp = 1.f + r2 * (-0.5f + r2 * (4.16666667e-2f + r2 * (-1.38888889e-3f + r2 * (2.48015873e-5f + r2 * -2.75573192e-7f))));
    s = (q == 0) ? sp : (q == 1) ? cp : (q == 2) ? -sp : -cp;
    c = (q == 0) ? cp : (q == 1) ? -sp : (q == 2) ? -cp : sp;
}
struct SsmIn { const float *a_re, *a_im, *log_dt, *b_re, *b_im, *c_re, *c_im, *d; };
constexpr int SSM_HROW = 272;
constexpr int SSM_HTILE = 32 * SSM_HROW;
constexpr int SSM_E_OFF = NWAVES * SSM_HTILE;

__device__ __forceinline__ void ssm_unit(int b, int g, bf16_t* PROJ, const SsmIn& si, LAS unsigned char* lds, int wave, int lane) {
    asm volatile("" : "+v"(lane));
    const int n = lane & 31, hi = lane >> 5;
    const float dt = expf(si.log_dt[g]);
    float ar[2], ai[2], fre[2], fim[2];
#pragma unroll
    for (int s = 0; s < 2; ++s) { const int p = 32 * s + n;
        const float lre = si.a_re[g * 64 + p], lim = si.a_im[g * 64 + p];
        const float xx = lre * dt, th = lim * dt;
        const float em1 = xx * (1.f + xx * 0.5f * (1.f + xx * (1.f / 3.f) * (1.f + xx * 0.25f * (1.f + xx * 0.2f * (1.f + xx * (1.f / 6.f) * (1.f + xx * (1.f / 7.f)))))));
        const float mag = 1.f + em1;
        float sn, cs, sh, ch; sincos_acc(th, sn, cs); sincos_acc(0.5f * th, sh, ch);
        const float cm1 = -2.f * sh * sh;
        ar[s] = mag * cs; ai[s] = mag * sn;
        const float nre = em1 * cs + cm1, nim = mag * sn, den = lre * lre + lim * lim;
        fre[s] = (nre * lre + nim * lim) / den; fim[s] = (nim * lre - nre * lim) / den; }
    bf16x8 Bf[4];
#pragma unroll
    for (int s = 0; s < 2; ++s) { const int p = 32 * s + n; const float* br = si.b_re + ((size_t)(g * 64 + p)) * 16 + 8 * hi; const float* bi = si.b_im + ((size_t)(g * 64 + p)) * 16 + 8 * hi;
        float vr[8], vi[8];
#pragma unroll
        for (int j = 0; j < 8; ++j) { const float r_ = br[j], i_ = bi[j]; vr[j] = fre[s] * r_ - fim[s] * i_; vi[j] = fre[s] * i_ + fim[s] * r_; }
        u32x4 wr_, wi_; wr_.x = cvtpk(vr[0], vr[1]); wr_.y = cvtpk(vr[2], vr[3]); wr_.z = cvtpk(vr[4], vr[5]); wr_.w = cvtpk(vr[6], vr[7]);
        wi_.x = cvtpk(vi[0], vi[1]); wi_.y = cvtpk(vi[2], vi[3]); wi_.z = cvtpk(vi[4], vi[5]); wi_.w = cvtpk(vi[6], vi[7]);
        Bf[2 * s] = __builtin_bit_cast(bf16x8, wr_); Bf[2 * s + 1] = __builtin_bit_cast(bf16x8, wi_); }
    bf16x8 Cf[4];
    { const int c = lane & 15, q4 = lane >> 4;
#pragma unroll
        for (int ks = 0; ks < 4; ++ks) { float v[8];
#pragma unroll
            for (int j = 0; j < 8; ++j) { const int np = 8 * ks + 2 * q4 + (j >> 2), cb = j & 3; const int p = np + 32 * (cb >> 1);
                v[j] = (cb & 1) ? -si.c_im[((size_t)(g * 16 + c)) * 64 + p] : si.c_re[((size_t)(g * 16 + c)) * 64 + p]; }
            u32x4 w; w.x = cvtpk(v[0], v[1]); w.y = cvtpk(v[2], v[3]); w.z = cvtpk(v[4], v[5]); w.w = cvtpk(v[6], v[7]);
            Cf[ks] = __builtin_bit_cast(bf16x8, w); } }
    const int rho = n, ho = (rho >> 2) & 1, rr = (rho & 3) + 4 * (rho >> 3);
    bf16_t* ubase = PROJ + ((size_t)b * SEQ + 256 * (2 * wave + ho) + rr) * NIN + C_U + 16 * g + 8 * hi;
    LAS float* E = (LAS float*)(lds + SSM_E_OFF);
    const f32x16 z16 = {0.f, 0.f, 0.f, 0.f, 0.f, 0.f, 0.f, 0.f, 0.f, 0.f, 0.f, 0.f, 0.f, 0.f, 0.f, 0.f};
    float hre[2] = {0.f, 0.f}, him[2] = {0.f, 0.f};
    {
        bf16x8 ufa[16];
#pragma unroll
        for (int blk = 0; blk < 16; ++blk) ufa[blk] = *(const bf16x8*)(ubase + (size_t)(16 * blk) * NIN);
#pragma unroll
        for (int blk = 0; blk < 16; ++blk) {
            f32x16 a4[4];
#pragma unroll
            for (int cb = 0; cb < 4; ++cb) a4[cb] = __builtin_amdgcn_mfma_f32_32x32x16_bf16(ufa[blk], Bf[cb], z16, 0, 0, 0);
#pragma unroll
            for (int r = 0; r < 16; ++r) {
#pragma unroll
                for (int s = 0; s < 2; ++s) { const float tr = fmaf(-ai[s], him[s], a4[2 * s][r]), ti = fmaf(ai[s], hre[s], a4[2 * s + 1][r]);
                    hre[s] = fmaf(ar[s], hre[s], tr); him[s] = fmaf(ar[s], him[s], ti); } }
        }
        const int ss = 2 * wave + hi;
        E[ss * 128 + 0 * 32 + n] = hre[0]; E[ss * 128 + 1 * 32 + n] = him[0]; E[ss * 128 + 2 * 32 + n] = hre[1]; E[ss * 128 + 3 * 32 + n] = him[1];
    }
    __syncthreads();
    {
        float pr[2], pi[2];
#pragma unroll
        for (int s = 0; s < 2; ++s) { pr[s] = ar[s]; pi[s] = ai[s];
#pragma unroll
            for (int i = 0; i < 8; ++i) { const float t = pr[s] * pr[s] - pi[s] * pi[s]; pi[s] = 2.f * pr[s] * pi[s]; pr[s] = t; } }
        const int ss = 2 * wave + hi;
        hre[0] = hre[1] = him[0] = him[1] = 0.f;
        for (int k = 0; k < 15; ++k) { if (k < ss) {
#pragma unroll
                for (int s = 0; s < 2; ++s) { const float er = E[k * 128 + (2 * s) * 32 + n], ei = E[k * 128 + (2 * s + 1) * 32 + n];
                    const float t = pr[s] * hre[s] - pi[s] * him[s] + er; him[s] = pr[s] * him[s] + pi[s] * hre[s] + ei; hre[s] = t; } } }
    }
    {
        LAS unsigned char* Ht = lds + wave * SSM_HTILE;
        const int tk = lane & 15, q4 = lane >> 4;
        f32x4 dsk = *(const f32x4*)(si.d + 16 * g + 4 * q4);
        bf16_t* upw = PROJ + ((size_t)b * SEQ + 256 * (2 * wave) + 256 * (q4 & 1) + tk) * NIN + C_U + 16 * g + 4 * (q4 & ~1);
        bf16x8 ufc[4]; u32x4 uzc[4];
#pragma unroll
        for (int bi = 0; bi < 4; ++bi) { ufc[bi] = *(const bf16x8*)(ubase + (size_t)(16 * bi) * NIN); uzc[bi] = *(const u32x4*)(upw + (size_t)(16 * bi) * NIN); }
        for (int grp = 0; grp < 4; ++grp) {
            bf16x8 ufn[4]; u32x4 uzn[4];
#pragma unroll
            for (int bi = 0; bi < 4; ++bi) { const int nb = (grp < 3) ? 4 * (grp + 1) + bi : bi;
                ufn[bi] = *(const bf16x8*)(ubase + (size_t)(16 * nb) * NIN); uzn[bi] = *(const u32x4*)(upw + (size_t)(16 * nb) * NIN); }
#pragma unroll
            for (int bi = 0; bi < 4; ++bi) {
                const int blk = 4 * grp + bi;
                f32x16 a4[4];
#pragma unroll
                for (int cb = 0; cb < 4; ++cb) a4[cb] = __builtin_amdgcn_mfma_f32_32x32x16_bf16(ufc[bi], Bf[cb], z16, 0, 0, 0);
#pragma unroll
                for (int r = 0; r < 16; ++r) {
#pragma unroll
                    for (int s = 0; s < 2; ++s) { const float tr = fmaf(-ai[s], him[s], a4[2 * s][r]), ti = fmaf(ai[s], hre[s], a4[2 * s + 1][r]);
                        hre[s] = fmaf(ar[s], hre[s], tr); him[s] = fmaf(ar[s], him[s], ti); }
                    u32x2 w; w.x = cvtpk(hre[0], him[0]); w.y = cvtpk(hre[1], him[1]);
                    *(LAS u32x2*)(Ht + (16 * hi + r) * SSM_HROW + 8 * n) = w; }
                asm volatile("s_waitcnt lgkmcnt(0)" ::: "memory");
                const u32x4 uz = uzc[bi];
                const auto e0 = __builtin_amdgcn_permlane16_swap(uz.x, uz.z, false, false), e1 = __builtin_amdgcn_permlane16_swap(uz.y, uz.w, false, false);
                const unsigned ux[2] = {e0[0], e0[1]}, uy[2] = {e1[0], e1[1]};
                unsigned wx[2], wy[2];
#pragma unroll
                for (int tb = 0; tb < 2; ++tb) {
                    f32x4 y = {0.f, 0.f, 0.f, 0.f};
#pragma unroll
                    for (int ks = 0; ks < 4; ++ks) { const bf16x8 hb = *(const LAS bf16x8*)(Ht + (16 * tb + tk) * SSM_HROW + (32 * ks + 8 * q4) * 2);
                        y = __builtin_amdgcn_mfma_f32_16x16x32_bf16(Cf[ks], hb, y, 0, 0, 0); }
                    const float y0 = gelu_tanh_f(y[0] + dsk[0] * bflo(ux[tb])), y1 = gelu_tanh_f(y[1] + dsk[1] * bfhi(ux[tb]));
                    const float y2 = gelu_tanh_f(y[2] + dsk[2] * bflo(uy[tb])), y3 = gelu_tanh_f(y[3] + dsk[3] * bfhi(uy[tb]));
                    wx[tb] = cvtpk(y0, y1); wy[tb] = cvtpk(y2, y3);
                }
                { const auto f0 = __builtin_amdgcn_permlane16_swap(wx[0], wx[1], false, false), f1 = __builtin_amdgcn_permlane16_swap(wy[0], wy[1], false, false);
                  u32x4 w; w.x = f0[0]; w.y = f1[0]; w.z = f0[1]; w.w = f1[1];
                  *(u32x4*)(upw + (size_t)(16 * blk) * NIN) = w; }
                asm volatile("s_waitcnt lgkmcnt(0)" ::: "memory");
            }
#pragma unroll
            for (int bi = 0; bi < 4; ++bi) { ufc[bi] = ufn[bi]; uzc[bi] = uzn[bi]; }
        }
    }
    __syncthreads();
}

constexpr int ATT_WAVE_LDS = 2 * 4096 + 1024;
__device__ __forceinline__ void attn_build_table(const float* rel_bias, int h, LAS unsigned char* wl, int lane) {
    LAS float* T = (LAS float*)(wl + 8192);
    const float c0 = rel_bias[h * 192 + 191];
#pragma unroll
    for (int i = 0; i < 4; ++i) { const int idx = lane + 64 * i; T[idx] = (idx < 191) ? (rel_bias[h * 192 + idx] - c0) * LOG2E : 0.f; }
    asm volatile("s_waitcnt lgkmcnt(0)" ::: "memory");
}
__device__ __forceinline__ void attn_unit(int b, int nchunk, int h, bf16_t* PROJ, LAS unsigned char* wl, int lane) {
    asm volatile("" : "+v"(lane));
    const int q32 = lane & 31, hi = lane >> 5;
    const LAS float* T = (const LAS float*)(wl + 8192);
    const size_t tok0 = (size_t)b * SEQ + (size_t)nchunk * 64;
    bf16x8 qf[2][4];
#pragma unroll
    for (int qb = 0; qb < 2; ++qb)
#pragma unroll
        for (int ds = 0; ds < 4; ++ds) qf[qb][ds] = *(const bf16x8*)(PROJ + (tok0 + 32 * qb + q32) * NIN + C_Q + h * 64 + 16 * ds + 8 * hi);
    f32x16 o[2][2];
#pragma unroll
    for (int db = 0; db < 2; ++db)
#pragma unroll
        for (int qb = 0; qb < 2; ++qb)
#pragma unroll
            for (int r = 0; r < 16; ++r) o[db][qb][r] = 0.f;
    float mrun[2] = {-1e30f, -1e30f}, lrun[2] = {0.f, 0.f};
    const int j0 = (nchunk < 8) ? (8 - nchunk) : 0;
    const int t0 = 2 * j0;
    const int ntl = 18 - t0;
#define TILE_OF(idx) ((nchunk >= 8) ? 2 * ((((idx) >> 1) + 80 - nchunk) % 9) + ((idx) & 1) : t0 + (idx))
#define KTOK(t) ((size_t)b * SEQ + (size_t)(nchunk - 8 + ((t) >> 1)) * 64 + 32 * ((t) & 1))
    bf16x8 kf[4]; u32x4 vch[4];
    { const size_t kt = KTOK(TILE_OF(0));
#pragma unroll
        for (int ds = 0; ds < 4; ++ds) kf[ds] = *(const bf16x8*)(PROJ + (kt + q32) * NIN + C_K + h * 64 + 16 * ds + 8 * hi);
#pragma unroll
        for (int i = 0; i < 4; ++i) { const int cc = lane + 64 * i, key = cc >> 3, c8 = cc & 7; vch[i] = *(const u32x4*)(PROJ + (kt + key) * NIN + C_V + h * 64 + 8 * c8); }
#pragma unroll
        for (int i = 0; i < 4; ++i) { const int cc = lane + 64 * i, key = cc >> 3, c8 = cc & 7; *(LAS u32x4*)(wl + 0 * 4096 + (c8 >> 2) * 2048 + key * 64 + (c8 & 3) * 16) = vch[i]; }
    }
    const int gI = lane >> 4, li = lane & 15, qrow = li >> 2, pp = li & 3;
    const int vtr_off = (4 * hi + qrow) * 64 + (16 * (gI & 1) + 4 * pp) * 2;
    for (int idx = 0; idx < ntl; ++idx) {
        const int t = TILE_OF(idx);
        bf16x8 kfn[4];
        const bool more = (idx + 1 < ntl);
        if (more) { const size_t kt = KTOK(TILE_OF(idx + 1));
#pragma unroll
            for (int ds = 0; ds < 4; ++ds) kfn[ds] = *(const bf16x8*)(PROJ + (kt + q32) * NIN + C_K + h * 64 + 16 * ds + 8 * hi);
#pragma unroll
            for (int i = 0; i < 4; ++i) { const int cc = lane + 64 * i, key = cc >> 3, c8 = cc & 7; vch[i] = *(const u32x4*)(PROJ + (kt + key) * NIN + C_V + h * 64 + 8 * c8); }
        } else {
#pragma unroll
            for (int ds = 0; ds < 4; ++ds) kfn[ds] = kf[ds];
        }
        const int j = t >> 1, kb = t & 1;
        f32x16 s[2];
        if (j >= 6) {
#pragma unroll
            for (int qb = 0; qb < 2; ++qb) { const int base = 32 * qb + q32 - 32 * kb - 4 * hi + 64 * (8 - j) + 63;
#pragma unroll
                for (int r = 0; r < 16; ++r) s[qb][r] = T[base - ((r & 3) + 8 * (r >> 2))]; }
        } else {
#pragma unroll
            for (int qb = 0; qb < 2; ++qb)
#pragma unroll
                for (int r = 0; r < 16; ++r) s[qb][r] = 0.f;
        }
#pragma unroll
        for (int ds = 0; ds < 4; ++ds)
#pragma unroll
            for (int qb = 0; qb < 2; ++qb) s[qb] = __builtin_amdgcn_mfma_f32_32x32x16_bf16(kf[ds], qf[qb][ds], s[qb], 0, 0, 0);
        bf16x8 pf[2][2];
#pragma unroll
        for (int qb = 0; qb < 2; ++qb) {
            float mx = s[qb][0];
#pragma unroll
            for (int r = 1; r < 16; ++r) mx = fmaxf(mx, s[qb][r]);
            mx = fmaxf(mx, __shfl_xor(mx, 32));
            const float mnew = fmaxf(mrun[qb], mx);
            const float alpha = __builtin_amdgcn_exp2f(mrun[qb] - mnew);
            mrun[qb] = mnew;
            float ls = 0.f;
#pragma unroll
            for (int r = 0; r < 16; ++r) { const float p = __builtin_amdgcn_exp2f(s[qb][r] - mnew); s[qb][r] = p; ls += p; }
            lrun[qb] = lrun[qb] * alpha + ls;
#pragma unroll
            for (int db = 0; db < 2; ++db)
#pragma unroll
                for (int r = 0; r < 16; ++r) o[db][qb][r] *= alpha;
#pragma unroll
            for (int s2 = 0; s2 < 2; ++s2) { u32x4 w; w.x = cvtpk(s[qb][8 * s2 + 0], s[qb][8 * s2 + 1]); w.y = cvtpk(s[qb][8 * s2 + 2], s[qb][8 * s2 + 3]);
                w.z = cvtpk(s[qb][8 * s2 + 4], s[qb][8 * s2 + 5]); w.w = cvtpk(s[qb][8 * s2 + 6], s[qb][8 * s2 + 7]); pf[qb][s2] = __builtin_bit_cast(bf16x8, w); }
        }
        asm volatile("s_waitcnt lgkmcnt(0)" ::: "memory");
        { LAS unsigned char* vb = wl + (idx & 1) * 4096 + vtr_off;
#pragma unroll
            for (int db = 0; db < 2; ++db)
#pragma unroll
                for (int s2 = 0; s2 < 2; ++s2) {
                    const s16x4 lo = __builtin_bit_cast(s16x4, __builtin_amdgcn_ds_read_tr16_b64_v4i16((LAS s16x4*)(vb + db * 2048 + (16 * s2) * 64)));
                    const s16x4 hh = __builtin_bit_cast(s16x4, __builtin_amdgcn_ds_read_tr16_b64_v4i16((LAS s16x4*)(vb + db * 2048 + (16 * s2 + 8) * 64)));
                    const bf16x8 vf = {lo[0], lo[1], lo[2], lo[3], hh[0], hh[1], hh[2], hh[3]};
#pragma unroll
                    for (int qb = 0; qb < 2; ++qb) o[db][qb] = __builtin_amdgcn_mfma_f32_32x32x16_bf16(vf, pf[qb][s2], o[db][qb], 0, 0, 0);
                } }
        asm volatile("s_waitcnt lgkmcnt(0)" ::: "memory");
        if (more) {
#pragma unroll
            for (int i = 0; i < 4; ++i) { const int cc = lane + 64 * i, key = cc >> 3, c8 = cc & 7; *(LAS u32x4*)(wl + ((idx + 1) & 1) * 4096 + (c8 >> 2) * 2048 + key * 64 + (c8 & 3) * 16) = vch[i]; }
        }
#pragma unroll
        for (int ds = 0; ds < 4; ++ds) kf[ds] = kfn[ds];
    }
#undef KTOK
#undef TILE_OF
    {
        u32x4 zq[2][2][2];
#pragma unroll
        for (int qb = 0; qb < 2; ++qb)
#pragma unroll
            for (int db = 0; db < 2; ++db)
#pragma unroll
                for (int k = 0; k < 2; ++k) zq[qb][db][k] = *(const u32x4*)(PROJ + (tok0 + 32 * qb + q32) * NIN + h * 64 + C_ZA + 32 * db + 16 * k + 8 * hi);
#pragma unroll
        for (int qb = 0; qb < 2; ++qb) {
            const float lt = lrun[qb] + __shfl_xor(lrun[qb], 32);
            const float inv = 1.0f / lt;
            bf16_t* rowp = PROJ + (tok0 + 32 * qb + q32) * NIN + h * 64;
#pragma unroll
            for (int db = 0; db < 2; ++db)
#pragma unroll
                for (int k = 0; k < 2; ++k) {
                    const u32x4 z = zq[qb][db][k];
                    const auto s0 = __builtin_amdgcn_permlane32_swap(z.x, z.z, false, false), s1 = __builtin_amdgcn_permlane32_swap(z.y, z.w, false, false);
                    const unsigned ax = s0[0], bx = s0[1], ay = s1[0], by = s1[1];
                    const unsigned wax = cvtpk(o[db][qb][8 * k + 0] * inv * bflo(ax), o[db][qb][8 * k + 1] * inv * bfhi(ax));
                    const unsigned way = cvtpk(o[db][qb][8 * k + 2] * inv * bflo(ay), o[db][qb][8 * k + 3] * inv * bfhi(ay));
                    const unsigned wbx = cvtpk(o[db][qb][8 * k + 4] * inv * bflo(bx), o[db][qb][8 * k + 5] * inv * bfhi(bx));
                    const unsigned wby = cvtpk(o[db][qb][8 * k + 6] * inv * bflo(by), o[db][qb][8 * k + 7] * inv * bfhi(by));
                    const auto t0 = __builtin_amdgcn_permlane32_swap(wax, wbx, false, false), t1 = __builtin_amdgcn_permlane32_swap(way, wby, false, false);
                    u32x4 w; w.x = t0[0]; w.y = t1[0]; w.z = t0[1]; w.w = t1[1];
                    *(u32x4*)(rowp + C_Q + 32 * db + 16 * k + 8 * hi) = w; }
        }
    }
    asm volatile("s_waitcnt lgkmcnt(0)" ::: "memory");
}

#define XB_TMO      128
#define XB_XCNT(j)  (256  + 64 * (j))
#define XB_XSUB(j)  (1280 + 64 * (j))
#define XB_XGEN(j)  (2304 + 64 * (j))
#define XB_TOP      3328
#define XB_TOPGEN   3392
#define XCD_BAR_WORDS 3456
#define XB_SPIN_CAP (1u << 20)
__device__ __forceinline__ unsigned xb_ld(unsigned* p)              { return __hip_atomic_load(p, __ATOMIC_RELAXED, __HIP_MEMORY_SCOPE_AGENT); }
__device__ __forceinline__ unsigned xb_add(unsigned* p, unsigned v) { return __hip_atomic_fetch_add(p, v, __ATOMIC_RELAXED, __HIP_MEMORY_SCOPE_AGENT); }
__device__ __forceinline__ unsigned xb_xcc_id() { return (unsigned)__builtin_amdgcn_s_getreg((3 << 11) | 20) & 0xFu; }
#define XB_SPIN(cond, bar) do { unsigned _sp = 0; while (cond) { __builtin_amdgcn_s_sleep(1); \
    if ((++_sp & 255u) == 0u) { if (xb_ld(&(bar)[XB_TMO])) break; if (_sp > XB_SPIN_CAP) { atomicAdd(&(bar)[XB_TMO], 1u); break; } } } } while (0)
struct XcdBarrier { unsigned* bar; unsigned x; volatile LAS unsigned* st; };
__device__ __forceinline__ XcdBarrier xcd_barrier_post(unsigned* bar, volatile LAS unsigned* st) {
    XcdBarrier b; b.bar = bar; b.x = xb_xcc_id(); b.st = st;
    if (threadIdx.x == 0) (void)xb_add(&bar[XB_XCNT(b.x)], 1u);
    return b;
}
__device__ __forceinline__ void xcd_barrier_complete(unsigned* bar, unsigned x, unsigned& nloc, unsigned& nx) {
    const unsigned G = gridDim.x * gridDim.y * gridDim.z;
    unsigned sum, cnt, mine, sp = 0u;
    for (;;) {
        sum = 0u; cnt = 0u; mine = 0u;
#pragma unroll
        for (unsigned j = 0; j < 16; ++j) { const unsigned c = xb_ld(&bar[XB_XCNT(j)]); sum += c; cnt += (c > 0u) ? 1u : 0u; mine = (j == x) ? c : mine; }
        if (sum == G) break;
        __builtin_amdgcn_s_sleep(1);
        if ((++sp & 255u) == 0u) { if (xb_ld(&bar[XB_TMO])) break; if (sp > XB_SPIN_CAP) { atomicAdd(&bar[XB_TMO], 1u); break; } }
    }
    nloc = mine > 0u ? mine : 1u; nx = cnt > 0u ? cnt : 1u;
}
__device__ __forceinline__ void xcd_barrier(const XcdBarrier& b) {
    asm volatile("s_waitcnt vmcnt(0)" ::: "memory");
    __syncthreads();
    if (threadIdx.x == 0) {
        unsigned* bar = b.bar;
        __builtin_amdgcn_s_waitcnt(0);
        unsigned nloc = b.st[0], nx = b.st[1];
        if (nloc == 0u) { xcd_barrier_complete(bar, b.x, nloc, nx); b.st[0] = nloc; b.st[1] = nx; }
        const unsigned old = xb_add(&bar[XB_XSUB(b.x)], 1u);
        const unsigned gen = old / nloc;
        if (old + 1u == (gen + 1u) * nloc) {
            __builtin_amdgcn_fence(__ATOMIC_RELEASE, "agent");
            asm volatile("s_waitcnt vmcnt(0)" ::: "memory");
            const unsigned og = xb_add(&bar[XB_TOP], 1u);
            const unsigned tg = og / nx;
            if (og + 1u == (tg + 1u) * nx) xb_add(&bar[XB_TOPGEN], 1u);
            else XB_SPIN(xb_ld(&bar[XB_TOPGEN]) == tg, bar);
            __builtin_amdgcn_fence(__ATOMIC_ACQUIRE, "agent");
            xb_add(&bar[XB_XGEN(b.x)], 1u);
            asm volatile("s_waitcnt vmcnt(0)" ::: "memory");
        } else {
            XB_SPIN(xb_ld(&bar[XB_XGEN(b.x)]) == gen, bar);
            __builtin_amdgcn_fence(__ATOMIC_ACQUIRE, "agent");
            asm volatile("s_waitcnt vmcnt(0)" ::: "memory");
        }
    }
    __syncthreads();
}

__device__ __forceinline__ void group_sync(unsigned* cnt, int wave) {
    asm volatile("s_waitcnt vmcnt(0)" ::: "memory");
    __syncthreads();
    if (wave == 0) {
        if (__lane_id() == 0) __hip_atomic_fetch_add(cnt, 1u, __ATOMIC_RELAXED, __HIP_MEMORY_SCOPE_AGENT);
        unsigned sp = 0;
        while ((unsigned)__builtin_amdgcn_readfirstlane(__hip_atomic_load(cnt, __ATOMIC_RELAXED, __HIP_MEMORY_SCOPE_AGENT)) < 4u) { __builtin_amdgcn_s_sleep(2); if (++sp > (1u << 22)) break; }
        __builtin_amdgcn_fence(__ATOMIC_ACQUIRE, "agent");
    }
    asm volatile("s_waitcnt vmcnt(0) lgkmcnt(0)" ::: "memory");
    __syncthreads();
}

struct Args {
    const float* in[19]; float* out; unsigned char* ws; int use_cg; int pad;
};

__global__ void __launch_bounds__(NWAVES * 64, 2) fwd_megakernel(Args a) {
    extern __shared__ __attribute__((aligned(16))) unsigned char lds_raw[];
    LAS unsigned char* lds = (LAS unsigned char*)lds_raw;
    cg::grid_group grid = cg::this_grid();
    const int tid = threadIdx.x, lane = tid & 63, wave = __builtin_amdgcn_readfirstlane(tid >> 6);
    const int G = gridDim.x, bx = blockIdx.x;
    if (tid < 2) ((volatile LAS unsigned*)(lds + MISC_OFF))[tid] = 0u;
    __syncthreads();
    const XcdBarrier xbar = xcd_barrier_post((unsigned*)(a.ws + WS_CTL), (volatile LAS unsigned*)(lds + MISC_OFF));
#define TS(i) do { if (PROBE_A >= 0 && bx == 0 && tid == 0) ((volatile LAS unsigned long long*)(lds + MISC_OFF + 64))[i] = __builtin_amdgcn_s_memrealtime(); } while (0)
    TS(0);
#define GRID_SEAM() do { if (a.use_cg) grid.sync(); else xcd_barrier(xbar); } while (0)
    const int vcu = (G % 8 == 0) ? (bx % 8) * (G / 8) + bx / 8 : bx;
    unsigned char* ws = a.ws;
    const float* x = a.in[0];
    bf16_t* WinT = (bf16_t*)(ws + WS_WIN); bf16_t* WgluT = (bf16_t*)(ws + WS_WGLU); bf16_t* WaoT = (bf16_t*)(ws + WS_WAO);
    bf16_t* WsoT = (bf16_t*)(ws + WS_WSO); bf16_t* WoutT = (bf16_t*)(ws + WS_WOUT);
    float* SSQ = (float*)(ws + WS_SSQ);
    bf16_t* XN = (bf16_t*)(ws + WS_XN);
    bf16_t* PROJ = (bf16_t*)(ws + WS_PROJ);

    {
        LAS float* scr = (LAS float*)(lds + wave * 16384);
        const int gw = bx * NWAVES + wave, NGW = G * NWAVES;
        constexpr int I_IN = (DM / 64) * (NIN / 32), I_GLU = (512 / 64) * (1024 / 32), I_AO = I_GLU, I_SO = I_GLU, I_OUT = (DM / 64) * (DM / 32);
        constexpr int NITEMS = I_IN + I_GLU + I_AO + I_SO + I_OUT;
        for (int it = gw; it < NITEMS; it += NGW) {
            int r = it;
            if (r < I_IN) { p0_transpose_item(a.in[2], DM, NIN, WinT, 2, scr, r, lane); continue; } r -= I_IN;
            if (r < I_GLU) { p0_transpose_item(a.in[12], 512, 1024, WgluT, 1, scr, r, lane); continue; } r -= I_GLU;
            if (r < I_AO) { p0_transpose_item(a.in[14], 512, 1024, WaoT, 0, scr, r, lane); continue; } r -= I_AO;
            if (r < I_SO) { p0_transpose_item(a.in[15], 512, 1024, WsoT, 0, scr, r, lane); continue; } r -= I_SO;
            p0_transpose_item(a.in[17], DM, DM, WoutT, 0, scr, r, lane);
        }
        const float* gain = a.in[1];
        f32x4 gv[4];
#pragma unroll
        for (int j = 0; j < 4; ++j) gv[j] = *(const f32x4*)(gain + 4 * lane + 256 * j);
        for (int m = gw; m < M_TOK; m += 2 * NGW) {
            const int m1 = m + NGW; const bool two = m1 < M_TOK;
            const f32x4* xr0 = (const f32x4*)(x + (size_t)m * DM) + lane; const f32x4* xr1 = (const f32x4*)(x + (size_t)(two ? m1 : m) * DM) + lane;
            f32x4 v[4], w4[4]; float s = 0.f, s1 = 0.f;
#pragma unroll
            for (int j = 0; j < 4; ++j) { v[j] = __builtin_nontemporal_load(&xr0[64 * j]); w4[j] = __builtin_nontemporal_load(&xr1[64 * j]); }
#pragma unroll
            for (int j = 0; j < 4; ++j) { s += (v[j][0] * v[j][0] + v[j][1] * v[j][1]) + (v[j][2] * v[j][2] + v[j][3] * v[j][3]); s1 += (w4[j][0] * w4[j][0] + w4[j][1] * w4[j][1]) + (w4[j][2] * w4[j][2] + w4[j][3] * w4[j][3]); }
            const float inv = 1.0f / sqrtf(wave_sum(s) * (1.f / DM) + NORM_EPS), inv1 = 1.0f / sqrtf(wave_sum(s1) * (1.f / DM) + NORM_EPS);
            u32x2* o8 = (u32x2*)(XN + (size_t)m * DM) + lane;
#pragma unroll
            for (int j = 0; j < 4; ++j) { u32x2 w; w.x = cvtpk(v[j][0] * inv * gv[j][0], v[j][1] * inv * gv[j][1]); w.y = cvtpk(v[j][2] * inv * gv[j][2], v[j][3] * inv * gv[j][3]); __builtin_nontemporal_store(w, &o8[64 * j]); }
            if (two) { u32x2* o9 = (u32x2*)(XN + (size_t)m1 * DM) + lane;
#pragma unroll
                for (int j = 0; j < 4; ++j) { u32x2 w; w.x = cvtpk(w4[j][0] * inv1 * gv[j][0], w4[j][1] * inv1 * gv[j][1]); w.y = cvtpk(w4[j][2] * inv1 * gv[j][2], w4[j][3] * inv1 * gv[j][3]); __builtin_nontemporal_store(w, &o9[64 * j]); } }
        }
    }
    GRID_SEAM(); TS(1);

    {
        pg8::Gemm g{XN, XN, WinT, WinT, DM, DM}; pg8::StaticOrder S; S.init(M_TOK, NIN, G, bx, 1);
        pg8::EpiProj E{PROJ, a.in[16]};
        pg8::gemm_phase<pg8::EpiProj>(lds, g, S, E);
    }
    GRID_SEAM(); TS(2);

    {
        SsmIn si{a.in[4], a.in[5], a.in[6], a.in[7], a.in[8], a.in[9], a.in[10], a.in[11]};
        for (int sidx = vcu; sidx < NBATCH * 32; sidx += G) ssm_unit(sidx >> 5, sidx & 31, PROJ, si, lds, wave, lane);
        TS(8);
        LAS unsigned char* wl = lds + wave * ATT_WAVE_LDS;
        attn_build_table(a.in[3], wave, wl, lane);
        const int NU = NBATCH * 64, per = (NU + G - 1) / G;
        for (int i = 0; i < per; ++i) { const int uidx = vcu * per + i; if (uidx < NU) attn_unit(uidx >> 6, uidx & 63, wave, PROJ, wl, lane); }
    }
    GRID_SEAM(); TS(3);

    {
        pg8::Gemm g{PROJ + C_U, PROJ + C_U, WgluT, WgluT, NIN, 512}; pg8::StaticOrder S; S.init(M_TOK, 1024, G, bx, 1);
        pg8::EpiGlu E{PROJ, a.in[13]};
        pg8::gemm_phase<pg8::EpiGlu>(lds, g, S, E);
    }
    if (G == 256) group_sync((unsigned*)(a.ws + WS_CTL + CTL_G3_OFF) + 64 * (bx & 63), wave); else GRID_SEAM();
    TS(4);

    {
        pg8::Gemm g{PROJ + C_Q, PROJ + C_ZS, WaoT, WsoT, NIN, 512}; pg8::StaticOrder S; S.init(M_TOK, DM, G, bx, 2);
        pg8::EpiMerge E{PROJ, XN};
        pg8::gemm_phase<pg8::EpiMerge>(lds, g, S, E);
    }
    if (G == 256) group_sync((unsigned*)(a.ws + WS_CTL + CTL_G4_OFF) + 64 * (bx & 63), wave); else GRID_SEAM();
    TS(5);

    {
        pg8::Gemm g{XN, XN, WoutT, WoutT, DM, DM}; pg8::StaticOrder S; S.init(M_TOK, DM, G, bx, 1);
        pg8::EpiOutNorm E{x, a.out, a.in[18], SSQ, (unsigned*)(a.ws + WS_CTL + CTL_CNT_OFF), lds};
        pg8::gemm_phase<pg8::EpiOutNorm>(lds, g, S, E);
    }
    TS(6);
    if (PROBE_A >= 0 && bx == 0 && tid == 0) {
        TS(7);
        volatile LAS unsigned long long* ts = (volatile LAS unsigned long long*)(lds + MISC_OFF + 64);
        const int ia0 = (PROBE_A == 8) ? 2 : PROBE_A, ia1 = (PROBE_A == 8) ? 8 : PROBE_A + 1, ib0 = (PROBE_B == 8) ? 2 : (PROBE_B == 10) ? 3 : PROBE_B, ib1 = (PROBE_B == 8) ? 8 : (PROBE_B == 10) ? 6 : PROBE_B + 1;
        const unsigned long long tA = (PROBE_A == 9) ? 0ull : ts[ia1] - ts[ia0], tB = ts[ib1] - ts[ib0];
        const unsigned long long X = 100000ull * ((tA + 250ull) / 500ull) + 2ull * tB;
        const unsigned long long t0 = __builtin_amdgcn_s_memrealtime();
        while (__builtin_amdgcn_s_memrealtime() - t0 < X) __builtin_amdgcn_s_sleep(8);
    }
}

extern "C" void kernel_launch(void* const* d_in, const int* in_sizes, int n_in, void* d_out, int out_size, void* d_ws, size_t ws_size, hipStream_t stream) {
    static int grid = 0;
    if (grid == 0) {
        if (n_in != 19 || in_sizes[0] != M_TOK * DM || out_size != M_TOK * DM || ws_size < WS_END) { fprintf(stderr, "kernel_launch: unexpected shapes (n_in %d, ws %zu)\n", n_in, ws_size); grid = -1; return; }
        int dev = 0, cus = 0, per_cu = 0;
        hipGetDevice(&dev);
        hipDeviceGetAttribute(&cus, hipDeviceAttributeMultiprocessorCount, dev);
        hipFuncSetAttribute((const void*)fwd_megakernel, hipFuncAttributeMaxDynamicSharedMemorySize, LDS_BYTES);
        hipOccupancyMaxActiveBlocksPerMultiprocessor(&per_cu, (const void*)fwd_megakernel, NWAVES * 64, LDS_BYTES);
        if (per_cu < 1) per_cu = 1;
        grid = cus * per_cu;
        (void)hipGetLastError();
    }
    if (grid < 0) return;
    Args a{};
    for (int i = 0; i < 19; ++i) a.in[i] = (const float*)d_in[i];
    a.out = (float*)d_out; a.ws = (unsigned char*)d_ws; a.use_cg = 0; a.pad = 0;
    if (hipMemsetAsync((char*)d_ws + WS_CTL, 0, CTL_ZERO_BYTES, stream) != hipSuccess) { fprintf(stderr, "kernel_launch: memset failed\n"); return; }
    void* args[] = {&a};
    hipError_t e = hipLaunchCooperativeKernel((const void*)fwd_megakernel, dim3(grid), dim3(NWAVES * 64), args, LDS_BYTES, stream);
    if (e != hipSuccess) fprintf(stderr, "cooperative launch failed: %s (grid %d)\n", hipGetErrorString(e), grid);
}
```

```cpp
#include <hip/hip_runtime.h>
#include <hip/hip_cooperative_groups.h>
#include <cstdio>
#include <cstdint>
namespace cg = cooperative_groups;

#define LAS __attribute__((address_space(3)))
typedef unsigned short bf16_t;
typedef short bf16x8 __attribute__((ext_vector_type(8)));
typedef short s16x4 __attribute__((ext_vector_type(4)));
typedef float f32x2 __attribute__((ext_vector_type(2)));
typedef float f32x4 __attribute__((ext_vector_type(4)));
typedef float f32x16 __attribute__((ext_vector_type(16)));
typedef unsigned u32x2 __attribute__((ext_vector_type(2)));
typedef unsigned u32x4 __attribute__((ext_vector_type(4)));
typedef __bf16 bf16x2_t __attribute__((ext_vector_type(2)));

constexpr int M_TOK = 32768, DM = 1024, NIN = 5120, SEQ = 4096, NBATCH = 8;
constexpr int C_Q = 0, C_K = 512, C_V = 1024, C_ZA = 1536, C_U = 2048, C_ZS = 2560, C_GA = 3072, C_GS = 4096;
constexpr float NORM_EPS = 1e-6f;
constexpr float LOG2E = 1.4426950408889634f;
constexpr size_t MiB = 1u << 20;
constexpr size_t WS_WIN = 0, WS_WGLU = 10 * MiB, WS_WAO = 11 * MiB, WS_WSO = 12 * MiB, WS_WOUT = 13 * MiB, WS_SSQ = 15 * MiB;
constexpr size_t WS_CTL = 17 * MiB, CTL_ZERO_BYTES = 98304, CTL_CNT_OFF = 16384, CTL_G3_OFF = 49152, CTL_G4_OFF = 65536;
constexpr size_t WS_XN = 32 * MiB;
constexpr size_t WS_PROJ = 96 * MiB;
constexpr size_t WS_END = 416 * MiB;
constexpr int LDS_BYTES = 147456;
constexpr int NWAVES = 8;
#ifndef PROBE_A
#define PROBE_A (-1)
#define PROBE_B (-1)
#endif
constexpr int MISC_OFF = 131072 + 64;

__device__ __forceinline__ unsigned cvtpk(float lo, float hi) { f32x2 v = {lo, hi}; bf16x2_t b = __builtin_convertvector(v, bf16x2_t); return __builtin_bit_cast(unsigned, b); }
__device__ __forceinline__ float bflo(unsigned w) { return __uint_as_float(w << 16); }
__device__ __forceinline__ float bfhi(unsigned w) { return __uint_as_float(w & 0xffff0000u); }
__device__ __forceinline__ float sigm(float x) { return __builtin_amdgcn_rcpf(1.f + __builtin_amdgcn_exp2f(-LOG2E * x)); }
__device__ __forceinline__ float silu_f(float x) { return x * sigm(x); }
__device__ __forceinline__ float gelu_tanh_f(float x) { return x * sigm(1.5957691216057308f * (x + 0.044715f * x * x * x)); }
__device__ __forceinline__ float wave_sum(float v) {
#pragma unroll
    for (int o = 1; o < 64; o <<= 1) v += __shfl_xor(v, o);
    return v;
}

namespace pg8 {
constexpr int BM = 256, BK = 64, HALF = 128, HTB = HALF * BK * 2, STAGE_BYTES = 8 * HTB, NXCD = 8, WGM = 8;
__host__ __device__ __forceinline__ int lds_byte(int r, int c) { const int st = (r >> 4) * 2 + (c >> 5), rr = r & 15, cc = c & 31, ob = rr * 64 + cc * 2; return st * 1024 + (ob ^ (((ob >> 9) & 1) << 5)); }
__host__ __device__ __forceinline__ void stage_rc(int b, int& R, int& C) { const int st = b / 1024, sb = b % 1024, swz = sb ^ (((sb >> 9) & 1) << 5); R = (st >> 1) * 16 + swz / 64; C = (st & 1) * 32 + (swz % 64) / 2; }
__host__ __device__ __forceinline__ int perm32(int rho) { const int n = rho >> 4, i = rho & 15; return 8 * (i >> 2) + 4 * n + (i & 3); }

struct Unit { int pm, pn, z; };
__device__ __forceinline__ void st16_wt(void* p, u32x4 v) { asm volatile("global_store_dwordx4 %0, %1, off sc1\n\ts_nop 0" :: "v"(p), "v"(v) : "memory");     }
struct Gemm { const bf16_t* A0; const bf16_t* A1; const bf16_t* B0; const bf16_t* B1; int lda, K; };

struct StaticOrder {
    int nM, nN, nwg, G, c, nz;
    __device__ void init(int M, int N, int G_, int c_, int nz_) { nM = M / BM; nN = N / BM; nwg = nM * nN; G = G_; c = c_; nz = nz_; }
    __device__ bool next(int i, Unit& u) const {
        const int ti = (nz == 2) ? (i >> 1) : i; u.z = (nz == 2) ? (i & 1) : 0;
        const long L = (long)ti * G + c; if (L >= nwg) return false;
        int wgid = (int)L; { const int q = nwg / NXCD, r = nwg % NXCD, xcd = wgid % NXCD, off = wgid / NXCD; wgid = (xcd < r ? xcd * (q + 1) : r * (q + 1) + (xcd - r) * q) + off; }
        const int nig = WGM * nN, gid = wgid / nig, fm = gid * WGM, gsz = (nM - fm) < WGM ? (nM - fm) : WGM;
        u.pm = fm + ((wgid % nig) % gsz); u.pn = (wgid % nig) / gsz; return true;
    }
};

template <class Epi>
__device__ __forceinline__ void gemm_phase(LAS unsigned char* lds, const Gemm g, const StaticOrder& S, const Epi& E) {
    int tid = threadIdx.x; asm volatile("" : "+v"(tid));
    const int wid = __builtin_amdgcn_readfirstlane(tid >> 6), lane = tid & 63, wr = wid >> 2, wc = wid & 3, fr = lane & 15, fq = lane >> 4;
    const int K = g.K, nt = K / BK, lda = g.lda;
    unsigned voffA[2], voffB[2];
#pragma unroll
    for (int i = 0; i < 2; ++i) { int R, C; stage_rc(tid * 16 + i * 8192, R, C); const int Rb = (R & ~31) + perm32(R & 31);
        voffA[i] = (unsigned)(R * lda + C) * 2u; voffB[i] = (unsigned)(Rb * K + C) * 2u; }
    const size_t kstep = (size_t)(BK * 2);
    const size_t hstepA = (size_t)HALF * lda * 2, tstepA = 2 * hstepA;
    const size_t hstepB = (size_t)HALF * K * 2, tstepB = 2 * hstepB;
    const unsigned ldsw = (unsigned)wid * 1024u;
    const int aoff = lds_byte(wr * 64 + fr, fq * 8), boff = lds_byte(wc * 32 + fr, fq * 8);
#define PG8_SA(b, h) (((b) * 2 + (h)) * HTB)
#define PG8_SB(b, h) ((4 + (b) * 2 + (h)) * HTB)
#define PG8_STAGE(bufoff, gbase, voff) do { _Pragma("unroll") for (int _i = 0; _i < 2; ++_i) \
        __builtin_amdgcn_global_load_lds((const unsigned*)((const char*)(gbase) + (voff)[_i]), (LAS unsigned*)(lds + (bufoff) + ldsw + _i * 8192), 16, 0, 0); } while (0)
#define PG8_LDA(dst, b, h) do { _Pragma("unroll") for (int m = 0; m < 4; ++m) _Pragma("unroll") for (int k = 0; k < 2; ++k) dst[m][k] = *(const LAS bf16x8*)(lds + PG8_SA(b, h) + aoff + m * 2048 + k * 1024); } while (0)
#define PG8_LDB(dst, b, h) do { _Pragma("unroll") for (int n = 0; n < 2; ++n) _Pragma("unroll") for (int k = 0; k < 2; ++k) dst[n][k] = *(const LAS bf16x8*)(lds + PG8_SB(b, h) + boff + n * 2048 + k * 1024); } while (0)
#define PG8_MMA(ai, bj, At, Bt) do { __builtin_amdgcn_s_setprio(1); _Pragma("unroll") for (int m = 0; m < 4; ++m) _Pragma("unroll") for (int n = 0; n < 2; ++n) _Pragma("unroll") for (int k = 0; k < 2; ++k) \
        acc[ai][bj][m][n] = __builtin_amdgcn_mfma_f32_16x16x32_bf16(Bt[n][k], At[m][k], acc[ai][bj][m][n], 0, 0, 0); __builtin_amdgcn_s_setprio(0); } while (0)
#define PG8_WAIT_V(n) asm volatile("s_waitcnt vmcnt(" #n ")" ::: "memory")
#define PG8_WAIT_L(n) asm volatile("s_waitcnt lgkmcnt(" #n ")" ::: "memory")
#define PG8_BAR __builtin_amdgcn_s_barrier()
#define PG8_SCHED __builtin_amdgcn_sched_barrier(0)
    Unit cur, nxt; int ui = 0;
    if (!S.next(0, cur)) return;
    f32x4 acc[2][2][4][2];
#pragma unroll
    for (int a = 0; a < 2; ++a)
#pragma unroll
        for (int b = 0; b < 2; ++b)
#pragma unroll
            for (int m = 0; m < 4; ++m)
#pragma unroll
                for (int n = 0; n < 2; ++n) acc[a][b][m][n] = (f32x4){0.f, 0.f, 0.f, 0.f};
    bf16x8 At[4][2], B0[2][2], B1[2][2];
    const char* cA = (const char*)(cur.z ? g.A1 : g.A0) + (size_t)cur.pm * tstepA; const char* cB = (const char*)(cur.z ? g.B1 : g.B0) + (size_t)cur.pn * tstepB;
    PG8_STAGE(PG8_SB(0, 0), cB, voffB); PG8_STAGE(PG8_SB(0, 1), cB + hstepB, voffB); PG8_STAGE(PG8_SA(0, 0), cA, voffA); PG8_STAGE(PG8_SA(0, 1), cA + hstepA, voffA);
    if (wr == 1) PG8_BAR;
    PG8_WAIT_V(2); PG8_BAR;
    PG8_STAGE(PG8_SB(1, 0), cB + kstep, voffB); PG8_STAGE(PG8_SA(1, 0), cA + kstep, voffA); PG8_STAGE(PG8_SB(1, 1), cB + hstepB + kstep, voffB);
    PG8_WAIT_V(6); PG8_BAR;
    for (;;) {
        const bool has_next = S.next(ui + 1, nxt);
        const char* nA = has_next ? (const char*)(nxt.z ? g.A1 : g.A0) + (size_t)nxt.pm * tstepA : cA; const char* nB = has_next ? (const char*)(nxt.z ? g.B1 : g.B0) + (size_t)nxt.pn * tstepB : cB;
        for (int t = 0; t < nt; t += 2) {
            const bool last = (t == nt - 2);
            const char* a1 = cA + (size_t)(t + 1) * kstep;
            const char* a2 = last ? nA : cA + (size_t)(t + 2) * kstep; const char* b2 = last ? nB : cB + (size_t)(t + 2) * kstep;
            const char* a3 = a2 + kstep; const char* b3 = b2 + kstep;
            PG8_LDB(B0, 0, 0); PG8_LDB(B1, 0, 1); PG8_SCHED; PG8_LDA(At, 0, 0); PG8_STAGE(PG8_SA(1, 1), a1 + hstepA, voffA);
            PG8_WAIT_V(8); PG8_WAIT_L(0); PG8_BAR; PG8_MMA(0, 0, At, B0); PG8_MMA(0, 1, At, B1); PG8_BAR; PG8_SCHED;
            PG8_LDA(At, 0, 1); PG8_STAGE(PG8_SB(0, 0), b2, voffB); PG8_STAGE(PG8_SB(0, 1), b2 + hstepB, voffB); PG8_STAGE(PG8_SA(0, 0), a2, voffA);
            PG8_WAIT_V(8); PG8_WAIT_L(0); PG8_BAR; PG8_MMA(1, 0, At, B0); PG8_MMA(1, 1, At, B1); PG8_BAR; PG8_SCHED;
            PG8_LDB(B0, 1, 0); PG8_LDB(B1, 1, 1); PG8_SCHED; PG8_LDA(At, 1, 0); PG8_STAGE(PG8_SA(0, 1), a2 + hstepA, voffA);
            PG8_WAIT_V(8); PG8_WAIT_L(0); PG8_BAR; PG8_MMA(0, 0, At, B0); PG8_MMA(0, 1, At, B1); PG8_BAR; PG8_SCHED;
            PG8_LDA(At, 1, 1); PG8_STAGE(PG8_SB(1, 0), b3, voffB); PG8_STAGE(PG8_SB(1, 1), b3 + hstepB, voffB); PG8_STAGE(PG8_SA(1, 0), a3, voffA);
            PG8_WAIT_V(8); PG8_WAIT_L(0); PG8_BAR; PG8_MMA(1, 0, At, B0); PG8_MMA(1, 1, At, B1); PG8_BAR; PG8_SCHED;
        }
        if (wr == 0) PG8_BAR;
        E(acc, cur, wr, wc, fr, fq);
        if (!has_next) break;
        if (!(Epi::CHAIN_Z && cur.z == 0)) {
#pragma unroll
        for (int a = 0; a < 2; ++a)
#pragma unroll
            for (int b = 0; b < 2; ++b)
#pragma unroll
                for (int m = 0; m < 4; ++m)
#pragma unroll
                    for (int n = 0; n < 2; ++n) acc[a][b][m][n] = (f32x4){0.f, 0.f, 0.f, 0.f};
        }
        cur = nxt; cA = nA; cB = nB; ++ui;
        if (wr == 1) PG8_BAR;
    }
    PG8_WAIT_V(0);
    PG8_BAR;
#undef PG8_SA
#undef PG8_SB
#undef PG8_STAGE
#undef PG8_LDA
#undef PG8_LDB
#undef PG8_MMA
#undef PG8_WAIT_V
#undef PG8_WAIT_L
#undef PG8_BAR
#undef PG8_SCHED
}

struct EpiProj {
    static constexpr bool CHAIN_Z = false;
    bf16_t* O; const float* gate_bias;
    __device__ __forceinline__ void operator()(f32x4 (&acc)[2][2][4][2], const Unit& u, int wr, int wc, int fr, int fq) const {
        const int pn = u.pn;
        const int mode = (pn < 2) ? 1 : (pn < 6) ? 0 : (pn < 8) ? 2 : (pn < 10) ? 0 : (pn < 12) ? 2 : 3;
        const int row0 = u.pm * BM + wr * 64 + fr, col0 = pn * BM + wc * 32 + 8 * fq;
        if (mode == 3) {
            const int j0 = (pn - 12) * HALF + wc * 32 + 8 * fq;
            f32x4 ba[2], bb[2];
#pragma unroll
            for (int n = 0; n < 2; ++n) { ba[n] = *(const f32x4*)(gate_bias + j0 + 4 * n); bb[n] = *(const f32x4*)(gate_bias + 1024 + j0 + 4 * n); }
#pragma unroll
            for (int ai = 0; ai < 2; ++ai)
#pragma unroll
                for (int m = 0; m < 4; ++m) { bf16_t* rowp = O + (size_t)(row0 + ai * HALF + m * 16) * NIN + col0; float rho[8], gs[8];
#pragma unroll
                    for (int n = 0; n < 2; ++n) { const f32x4 a = acc[ai][0][m][n] + ba[n], b = acc[ai][1][m][n] + bb[n];
#pragma unroll
                        for (int i = 0; i < 4; ++i) { const float ea = __builtin_amdgcn_exp2f(-LOG2E * a[i]), eb = __builtin_amdgcn_exp2f(-LOG2E * fmaxf(b[i], -40.f));
                            const float ia = __builtin_amdgcn_rcpf(1.f + ea); rho[4 * n + i] = (1.f + eb) * ia; gs[4 * n + i] = __builtin_amdgcn_rcpf(1.f + eb); } }
                    u32x4 w; w.x = cvtpk(rho[0], rho[1]); w.y = cvtpk(rho[2], rho[3]); w.z = cvtpk(rho[4], rho[5]); w.w = cvtpk(rho[6], rho[7]);
                    *(u32x4*)rowp = w;
                    w.x = cvtpk(gs[0], gs[1]); w.y = cvtpk(gs[2], gs[3]); w.z = cvtpk(gs[4], gs[5]); w.w = cvtpk(gs[6], gs[7]);
                    *(u32x4*)(rowp + HALF) = w; }
            return;
        }
#pragma unroll
        for (int ai = 0; ai < 2; ++ai)
#pragma unroll
            for (int m = 0; m < 4; ++m) { bf16_t* rowp = O + (size_t)(row0 + ai * HALF + m * 16) * NIN + col0;
#pragma unroll
                for (int bj = 0; bj < 2; ++bj) { f32x4 v0 = acc[ai][bj][m][0], v1 = acc[ai][bj][m][1];
                    if (mode == 1) { v0 = v0 * (0.125f * LOG2E); v1 = v1 * (0.125f * LOG2E); }
                    else if (mode == 2) {
#pragma unroll
                        for (int i = 0; i < 4; ++i) { v0[i] = silu_f(v0[i]); v1[i] = silu_f(v1[i]); } }
                    u32x4 w; w.x = cvtpk(v0[0], v0[1]); w.y = cvtpk(v0[2], v0[3]); w.z = cvtpk(v1[0], v1[1]); w.w = cvtpk(v1[2], v1[3]);
                    *(u32x4*)(rowp + bj * HALF) = w; } }
    }
};
struct EpiGlu {
    static constexpr bool CHAIN_Z = false;
    bf16_t* P; const float* b_glu;
    __device__ __forceinline__ void operator()(f32x4 (&acc)[2][2][4][2], const Unit& u, int wr, int wc, int fr, int fq) const {
        const int row0 = u.pm * BM + wr * 64 + fr, j0 = u.pn * HALF + wc * 32 + 8 * fq;
        f32x4 ba[2], bb[2];
#pragma unroll
        for (int n = 0; n < 2; ++n) { ba[n] = *(const f32x4*)(b_glu + j0 + 4 * n); bb[n] = *(const f32x4*)(b_glu + 512 + j0 + 4 * n); }
#pragma unroll
        for (int ai = 0; ai < 2; ++ai)
#pragma unroll
            for (int m = 0; m < 4; ++m) { bf16_t* zp = P + (size_t)(row0 + ai * HALF + m * 16) * NIN + C_ZS + j0;
                const u32x4 z = *(const u32x4*)zp; float r[8];
#pragma unroll
                for (int n = 0; n < 2; ++n) { const f32x4 a = acc[ai][0][m][n] + ba[n], b = acc[ai][1][m][n] + bb[n];
#pragma unroll
                    for (int i = 0; i < 4; ++i) r[4 * n + i] = a[i] * sigm(b[i]); }
                u32x4 w; w.x = cvtpk(r[0] * bflo(z.x), r[1] * bfhi(z.x)); w.y = cvtpk(r[2] * bflo(z.y), r[3] * bfhi(z.y));
                w.z = cvtpk(r[4] * bflo(z.z), r[5] * bfhi(z.z)); w.w = cvtpk(r[6] * bflo(z.w), r[7] * bfhi(z.w));
                st16_wt(zp, w); }
    }
};
struct EpiMerge {
    static constexpr bool CHAIN_Z = true;
    const bf16_t* P; bf16_t* MG;
    __device__ __forceinline__ void operator()(f32x4 (&acc)[2][2][4][2], const Unit& u, int wr, int wc, int fr, int fq) const {
        const int row0 = u.pm * BM + wr * 64 + fr, col0 = u.pn * BM + wc * 32 + 8 * fq;
        const int gcol0 = C_GA + 256 * (2 * u.pn) + (u.z ? HALF : 0) + wc * 32 + 8 * fq;
#pragma unroll
        for (int ai = 0; ai < 2; ++ai) {
            u32x4 gt[4][2];
#pragma unroll
            for (int m = 0; m < 4; ++m)
#pragma unroll
                for (int bj = 0; bj < 2; ++bj) gt[m][bj] = *(const u32x4*)(P + (size_t)(row0 + ai * HALF + m * 16) * NIN + gcol0 + 256 * bj);
#pragma unroll
            for (int m = 0; m < 4; ++m)
#pragma unroll
                for (int bj = 0; bj < 2; ++bj) { const u32x4 g4 = gt[m][bj];
                    f32x4 v0 = acc[ai][bj][m][0], v1 = acc[ai][bj][m][1];
                    v0[0] *= bflo(g4.x); v0[1] *= bfhi(g4.x); v0[2] *= bflo(g4.y); v0[3] *= bfhi(g4.y);
                    v1[0] *= bflo(g4.z); v1[1] *= bfhi(g4.z); v1[2] *= bflo(g4.w); v1[3] *= bfhi(g4.w);
                    if (u.z == 0) { acc[ai][bj][m][0] = v0; acc[ai][bj][m][1] = v1; }
                    else { u32x4 w; w.x = cvtpk(v0[0], v0[1]); w.y = cvtpk(v0[2], v0[3]); w.z = cvtpk(v1[0], v1[1]); w.w = cvtpk(v1[2], v1[3]);
                        st16_wt(MG + (size_t)(row0 + ai * HALF + m * 16) * DM + col0 + bj * HALF, w); } }
        }
    }
};
constexpr int EX_OFF = 131072 + 1024;
struct EpiOutNorm {
    static constexpr bool CHAIN_Z = false;
    const float* x; float* out; const float* gain; float* xbuf; unsigned* cnt; LAS unsigned char* lds;
    __device__ __forceinline__ void operator()(f32x4 (&acc)[2][2][4][2], const Unit& u, int wr, int wc, int fr, int fq) const {
        const int tid = threadIdx.x, wid = tid >> 6, lane = tid & 63;
        LAS float* P = (LAS float*)(lds + EX_OFF);
        LAS float* S = (LAS float*)(lds + EX_OFF + 4096);
        const int row0 = u.pm * BM + wr * 64 + fr, col0 = u.pn * BM + wc * 32 + 8 * fq;
#pragma unroll
        for (int ai = 0; ai < 2; ++ai)
#pragma unroll
            for (int m = 0; m < 4; ++m) { const size_t row = (size_t)(row0 + ai * HALF + m * 16); float s = 0.f;
#pragma unroll
                for (int bj = 0; bj < 2; ++bj) { const size_t o = row * DM + col0 + bj * HALF;
                    const f32x4 v0 = acc[ai][bj][m][0] + *(const f32x4*)(x + o), v1 = acc[ai][bj][m][1] + *(const f32x4*)(x + o + 4);
                    acc[ai][bj][m][0] = v0; acc[ai][bj][m][1] = v1;
                    s += (v0[0] * v0[0] + v0[1] * v0[1]) + (v0[2] * v0[2] + v0[3] * v0[3]) + (v1[0] * v1[0] + v1[1] * v1[1]) + (v1[2] * v1[2] + v1[3] * v1[3]); }
                s += __shfl_xor(s, 16); s += __shfl_xor(s, 32);
                if (fq == 0) P[(ai * HALF + wr * 64 + m * 16 + fr) * 4 + wc] = s; }
        asm volatile("s_waitcnt lgkmcnt(0)" ::: "memory"); __builtin_amdgcn_s_barrier(); asm volatile("" ::: "memory");
        const int prow = wid * 32 + (lane & 31);
        if (lane < 32) { const float t = (P[prow * 4 + 0] + P[prow * 4 + 1]) + (P[prow * 4 + 2] + P[prow * 4 + 3]);
            __hip_atomic_store(xbuf + ((size_t)(u.pm * BM + prow) * 4 + u.pn), t, __ATOMIC_RELAXED, __HIP_MEMORY_SCOPE_AGENT); }
        asm volatile("s_waitcnt vmcnt(0)" ::: "memory");
        if (lane == 0) __hip_atomic_fetch_add(cnt + 64 * u.pm, 1u, __ATOMIC_RELAXED, __HIP_MEMORY_SCOPE_AGENT);
        if (wid == 0) { unsigned sp = 0;
            while ((unsigned)__builtin_amdgcn_readfirstlane(__hip_atomic_load(cnt + 64 * u.pm, __ATOMIC_RELAXED, __HIP_MEMORY_SCOPE_AGENT)) < 32u) { __builtin_amdgcn_s_sleep(2); if (++sp > (1u << 22)) break; }
            __builtin_amdgcn_fence(__ATOMIC_ACQUIRE, "agent"); }
        asm volatile("s_waitcnt vmcnt(0) lgkmcnt(0)" ::: "memory"); __builtin_amdgcn_s_barrier(); asm volatile("" ::: "memory");
        if (lane < 32) { const float* sl = xbuf + (size_t)(u.pm * BM + prow) * 4; float q = 0.f;
#pragma unroll
            for (int t = 0; t < 4; ++t) q += __hip_atomic_load(sl + t, __ATOMIC_RELAXED, __HIP_MEMORY_SCOPE_AGENT);
            S[prow] = 1.0f / sqrtf(q * (1.f / DM) + NORM_EPS); }
        asm volatile("s_waitcnt lgkmcnt(0)" ::: "memory"); __builtin_amdgcn_s_barrier(); asm volatile("" ::: "memory");
        f32x4 gv[2][2];
#pragma unroll
        for (int bj = 0; bj < 2; ++bj)
#pragma unroll
            for (int n = 0; n < 2; ++n) gv[bj][n] = *(const f32x4*)(gain + col0 + bj * HALF + 4 * n);
#pragma unroll
        for (int ai = 0; ai < 2; ++ai)
#pragma unroll
            for (int m = 0; m < 4; ++m) { const int r = ai * HALF + wr * 64 + m * 16 + fr; const float inv = S[r]; const size_t row = (size_t)(u.pm * BM + r);
#pragma unroll
                for (int bj = 0; bj < 2; ++bj) { const size_t o = row * DM + col0 + bj * HALF;
                    *(f32x4*)(out + o) = acc[ai][bj][m][0] * inv * gv[bj][0]; *(f32x4*)(out + o + 4) = acc[ai][bj][m][1] * inv * gv[bj][1]; } }
        asm volatile("s_waitcnt lgkmcnt(0)" ::: "memory"); __builtin_amdgcn_s_barrier(); asm volatile("" ::: "memory");
    }
};
}

__device__ __forceinline__ void p0_transpose_item(const float* W, int K, int N, bf16_t* WT, int map, LAS float* scr, int item, int lane) {
    const int nblk = N / 32, kb = item / nblk, nb = item % nblk, k0 = 64 * kb, n0 = 32 * nb;
    int r0 = n0;
    if (map == 1) { const int bj = n0 >> 9, rem = n0 & 511, pn = rem >> 7, w = rem & 127; r0 = 256 * pn + 128 * bj + w; }
    if (map == 2 && n0 >= C_GA) { const int j0 = (n0 - C_GA) & 1023, isS = (n0 - C_GA) >> 10; r0 = C_GA + 256 * (j0 >> 7) + 128 * isS + (j0 & 127); }
#pragma unroll 8
    for (int i = 0; i < 32; ++i) { const int kk = 2 * i + (lane >> 5); scr[kk * 33 + (lane & 31)] = W[(size_t)(k0 + kk) * N + n0 + (lane & 31)]; }
    asm volatile("s_waitcnt lgkmcnt(0)" ::: "memory");
    const int c = lane & 7;
#pragma unroll
    for (int j = 0; j < 4; ++j) { const int n = (lane >> 3) + 8 * j; const LAS float* s = scr + (8 * c) * 33 + n;
        u32x4 o; o.x = cvtpk(s[0 * 33], s[1 * 33]); o.y = cvtpk(s[2 * 33], s[3 * 33]); o.z = cvtpk(s[4 * 33], s[5 * 33]); o.w = cvtpk(s[6 * 33], s[7 * 33]);
        *(u32x4*)(WT + (size_t)(r0 + n) * K + k0 + 8 * c) = o; }
    asm volatile("s_waitcnt lgkmcnt(0)" ::: "memory");
}

__device__ __forceinline__ void sincos_acc(float th, float& s, float& c) {
    const float k = rintf(th * 0.636619772f);
    float r = fmaf(-k, 1.57079637050628662109375f, th); r = fmaf(-k, -4.371139000186241e-08f, r);
    const int q = ((int)k) & 3; const float r2 = r * r;
    const float sp = r * (1.f + r2 * (-1.66666667e-1f + r2 * (8.33333333e-3f + r2 * (-1.98412698e-4f + r2 * 2.75573192e-6f))));
    const float cp = 1.f + r2 * (-0.5f + r2 * (4.16666667e-2f + r2 * (-1.38888889e-3f + r2 * (2.48015873e-5f + r2 * -2.75573192e-7f))));
    s = (q == 0) ? sp : (q == 1) ? cp : (q == 2) ? -sp : -cp;
    c = (q == 0) ? cp : (q == 1) ? -sp : (q == 2) ? -cp : sp;
}
struct SsmIn { const float *a_re, *a_im, *log_dt, *b_re, *b_im, *c_re, *c_im, *d; };
constexpr int SSM_HROW = 272;
constexpr int SSM_HTILE = 32 * SSM_HROW;
constexpr int SSM_E_OFF = NWAVES * SSM_HTILE;

__device__ __forceinline__ void ssm_unit(int b, int g, bf16_t* PROJ, const SsmIn& si, LAS unsigned char* lds, int wave, int lane) {
    asm volatile("" : "+v"(lane));
    const int n = lane & 31, hi = lane >> 5;
    const float dt = expf(si.log_dt[g]);
    float ar[2], ai[2], fre[2], fim[2];
#pragma unroll
    for (int s = 0; s < 2; ++s) { const int p = 32 * s + n;
        const float lre = si.a_re[g * 64 + p], lim = si.a_im[g * 64 + p];
        const float xx = lre * dt, th = lim * dt;
        const float em1 = xx * (1.f + xx * 0.5f * (1.f + xx * (1.f / 3.f) * (1.f + xx * 0.25f * (1.f + xx * 0.2f * (1.f + xx * (1.f / 6.f) * (1.f + xx * (1.f / 7.f)))))));
        const float mag = 1.f + em1;
        float sn, cs, sh, ch; sincos_acc(th, sn, cs); sincos_acc(0.5f * th, sh, ch);
        const float cm1 = -2.f * sh * sh;
        ar[s] = mag * cs; ai[s] = mag * sn;
        const float nre = em1 * cs + cm1, nim = mag * sn, den = lre * lre + lim * lim;
        fre[s] = (nre * lre + nim * lim) / den; fim[s] = (nim * lre - nre * lim) / den; }
    bf16x8 Bf[4];
#pragma unroll
    for (int s = 0; s < 2; ++s) { const int p = 32 * s + n; const float* br = si.b_re + ((size_t)(g * 64 + p)) * 16 + 8 * hi; const float* bi = si.b_im + ((size_t)(g * 64 + p)) * 16 + 8 * hi;
        float vr[8], vi[8];
#pragma unroll
        for (int j = 0; j < 8; ++j) { const float r_ = br[j], i_ = bi[j]; vr[j] = fre[s] * r_ - fim[s] * i_; vi[j] = fre[s] * i_ + fim[s] * r_; }
        u32x4 wr_, wi_; wr_.x = cvtpk(vr[0], vr[1]); wr_.y = cvtpk(vr[2], vr[3]); wr_.z = cvtpk(vr[4], vr[5]); wr_.w = cvtpk(vr[6], vr[7]);
        wi_.x = cvtpk(vi[0], vi[1]); wi_.y = cvtpk(vi[2], vi[3]); wi_.z = cvtpk(vi[4], vi[5]); wi_.w = cvtpk(vi[6], vi[7]);
        Bf[2 * s] = __builtin_bit_cast(bf16x8, wr_); Bf[2 * s + 1] = __builtin_bit_cast(bf16x8, wi_); }
    bf16x8 Cf[4];
    { const int c = lane & 15, q4 = lane >> 4;
#pragma unroll
        for (int ks = 0; ks < 4; ++ks) { float v[8];
#pragma unroll
            for (int j = 0; j < 8; ++j) { const int np = 8 * ks + 2 * q4 + (j >> 2), cb = j & 3; const int p = np + 32 * (cb >> 1);
                v[j] = (cb & 1) ? -si.c_im[((size_t)(g * 16 + c)) * 64 + p] : si.c_re[((size_t)(g * 16 + c)) * 64 + p]; }
            u32x4 w; w.x = cvtpk(v[0], v[1]); w.y = cvtpk(v[2], v[3]); w.z = cvtpk(v[4], v[5]); w.w = cvtpk(v[6], v[7]);
            Cf[ks] = __builtin_bit_cast(bf16x8, w); } }
    const int rho = n, ho = (rho >> 2) & 1, rr = (rho & 3) + 4 * (rho >> 3);
    bf16_t* ubase = PROJ + ((size_t)b * SEQ + 256 * (2 * wave + ho) + rr) * NIN + C_U + 16 * g + 8 * hi;
    LAS float* E = (LAS float*)(lds + SSM_E_OFF);
    const f32x16 z16 = {0.f, 0.f, 0.f, 0.f, 0.f, 0.f, 0.f, 0.f, 0.f, 0.f, 0.f, 0.f, 0.f, 0.f, 0.f, 0.f};
    float hre[2] = {0.f, 0.f}, him[2] = {0.f, 0.f};
    {
        bf16x8 ufa[16];
#pragma unroll
        for (int blk = 0; blk < 16; ++blk) ufa[blk] = *(const bf16x8*)(ubase + (size_t)(16 * blk) * NIN);
#pragma unroll
        for (int blk = 0; blk < 16; ++blk) {
            f32x16 a4[4];
#pragma unroll
            for (int cb = 0; cb < 4; ++cb) a4[cb] = __builtin_amdgcn_mfma_f32_32x32x16_bf16(ufa[blk], Bf[cb], z16, 0, 0, 0);
#pragma unroll
            for (int r = 0; r < 16; ++r) {
#pragma unroll
                for (int s = 0; s < 2; ++s) { const float tr = fmaf(-ai[s], him[s], a4[2 * s][r]), ti = fmaf(ai[s], hre[s], a4[2 * s + 1][r]);
                    hre[s] = fmaf(ar[s], hre[s], tr); him[s] = fmaf(ar[s], him[s], ti); } }
        }
        const int ss = 2 * wave + hi;
        E[ss * 128 + 0 * 32 + n] = hre[0]; E[ss * 128 + 1 * 32 + n] = him[0]; E[ss * 128 + 2 * 32 + n] = hre[1]; E[ss * 128 + 3 * 32 + n] = him[1];
    }
    __syncthreads();
    {
        float pr[2], pi[2];
#pragma unroll
        for (int s = 0; s < 2; ++s) { pr[s] = ar[s]; pi[s] = ai[s];
#pragma unroll
            for (int i = 0; i < 8; ++i) { const float t = pr[s] * pr[s] - pi[s] * pi[s]; pi[s] = 2.f * pr[s] * pi[s]; pr[s] = t; } }
        const int ss = 2 * wave + hi;
        hre[0] = hre[1] = him[0] = him[1] = 0.f;
        for (int k = 0; k < 15; ++k) { if (k < ss) {
#pragma unroll
                for (int s = 0; s < 2; ++s) { const float er = E[k * 128 + (2 * s) * 32 + n], ei = E[k * 128 + (2 * s + 1) * 32 + n];
                    const float t = pr[s] * hre[s] - pi[s] * him[s] + er; him[s] = pr[s] * him[s] + pi[s] * hre[s] + ei; hre[s] = t; } } }
    }
    {
        LAS unsigned char* Ht = lds + wave * SSM_HTILE;
        const int tk = lane & 15, q4 = lane >> 4;
        f32x4 dsk = *(const f32x4*)(si.d + 16 * g + 4 * q4);
        bf16_t* upw = PROJ + ((size_t)b * SEQ + 256 * (2 * wave) + 256 * (q4 & 1) + tk) * NIN + C_U + 16 * g + 4 * (q4 & ~1);
        bf16x8 ufc[4]; u32x4 uzc[4];
#pragma unroll
        for (int bi = 0; bi < 4; ++bi) { ufc[bi] = *(const bf16x8*)(ubase + (size_t)(16 * bi) * NIN); uzc[bi] = *(const u32x4*)(upw + (size_t)(16 * bi) * NIN); }
        for (int grp = 0; grp < 4; ++grp) {
            bf16x8 ufn[4]; u32x4 uzn[4];
#pragma unroll
            for (int bi = 0; bi < 4; ++bi) { const int nb = (grp < 3) ? 4 * (grp + 1) + bi : bi;
                ufn[bi] = *(const bf16x8*)(ubase + (size_t)(16 * nb) * NIN); uzn[bi] = *(const u32x4*)(upw + (size_t)(16 * nb) * NIN); }
#pragma unroll
            for (int bi = 0; bi < 4; ++bi) {
                const int blk = 4 * grp + bi;
                f32x16 a4[4];
#pragma unroll
                for (int cb = 0; cb < 4; ++cb) a4[cb] = __builtin_amdgcn_mfma_f32_32x32x16_bf16(ufc[bi], Bf[cb], z16, 0, 0, 0);
#pragma unroll
                for (int r = 0; r < 16; ++r) {
#pragma unroll
                    for (int s = 0; s < 2; ++s) { const float tr = fmaf(-ai[s], him[s], a4[2 * s][r]), ti = fmaf(ai[s], hre[s], a4[2 * s + 1][r]);
                        hre[s] = fmaf(ar[s], hre[s], tr); him[s] = fmaf(ar[s], him[s], ti); }
                    u32x2 w; w.x = cvtpk(hre[0], him[0]); w.y = cvtpk(hre[1], him[1]);
                    *(LAS u32x2*)(Ht + (16 * hi + r) * SSM_HROW + 8 * n) = w; }
                asm volatile("s_waitcnt lgkmcnt(0)" ::: "memory");
                const u32x4 uz = uzc[bi];
                const auto e0 = __builtin_amdgcn_permlane16_swap(uz.x, uz.z, false, false), e1 = __builtin_amdgcn_permlane16_swap(uz.y, uz.w, false, false);
                const unsigned ux[2] = {e0[0], e0[1]}, uy[2] = {e1[0], e1[1]};
                unsigned wx[2], wy[2];
#pragma unroll
                for (int tb = 0; tb < 2; ++tb) {
                    f32x4 y = {0.f, 0.f, 0.f, 0.f};
#pragma unroll
                    for (int ks = 0; ks < 4; ++ks) { const bf16x8 hb = *(const LAS bf16x8*)(Ht + (16 * tb + tk) * SSM_HROW + (32 * ks + 8 * q4) * 2);
                        y = __builtin_amdgcn_mfma_f32_16x16x32_bf16(Cf[ks], hb, y, 0, 0, 0); }
                    const float y0 = gelu_tanh_f(y[0] + dsk[0] * bflo(ux[tb])), y1 = gelu_tanh_f(y[1] + dsk[1] * bfhi(ux[tb]));
                    const float y2 = gelu_tanh_f(y[2] + dsk[2] * bflo(uy[tb])), y3 = gelu_tanh_f(y[3] + dsk[3] * bfhi(uy[tb]));
                    wx[tb] = cvtpk(y0, y1); wy[tb] = cvtpk(y2, y3);
                }
                { const auto f0 = __builtin_amdgcn_permlane16_swap(wx[0], wx[1], false, false), f1 = __builtin_amdgcn_permlane16_swap(wy[0], wy[1], false, false);
                  u32x4 w; w.x = f0[0]; w.y = f1[0]; w.z = f0[1]; w.w = f1[1];
                  *(u32x4*)(upw + (size_t)(16 * blk) * NIN) = w; }
                asm volatile("s_waitcnt lgkmcnt(0)" ::: "memory");
            }
#pragma unroll
            for (int bi = 0; bi < 4; ++bi) { ufc[bi] = ufn[bi]; uzc[bi] = uzn[bi]; }
        }
    }
    __syncthreads();
}

constexpr int ATT_WAVE_LDS = 2 * 4096 + 1024;
__device__ __forceinline__ void attn_build_table(const float* rel_bias, int h, LAS unsigned char* wl, int lane) {
    LAS float* T = (LAS float*)(wl + 8192);
    const float c0 = rel_bias[h * 192 + 191];
#pragma unroll
    for (int i = 0; i < 4; ++i) { const int idx = lane + 64 * i; T[idx] = (idx < 191) ? (rel_bias[h * 192 + idx] - c0) * LOG2E : 0.f; }
    asm volatile("s_waitcnt lgkmcnt(0)" ::: "memory");
}
__device__ __forceinline__ void attn_unit(int b, int nchunk, int h, bf16_t* PROJ, LAS unsigned char* wl, int lane) {
    asm volatile("" : "+v"(lane));
    const int q32 = lane & 31, hi = lane >> 5;
    const LAS float* T = (const LAS float*)(wl + 8192);
    const size_t tok0 = (size_t)b * SEQ + (size_t)nchunk * 64;
    bf16x8 qf[2][4];
#pragma unroll
    for (int qb = 0; qb < 2; ++qb)
#pragma unroll
        for (int ds = 0; ds < 4; ++ds) qf[qb][ds] = *(const bf16x8*)(PROJ + (tok0 + 32 * qb + q32) * NIN + C_Q + h * 64 + 16 * ds + 8 * hi);
    f32x16 o[2][2];
#pragma unroll
    for (int db = 0; db < 2; ++db)
#pragma unroll
        for (int qb = 0; qb < 2; ++qb)
#pragma unroll
            for (int r = 0; r < 16; ++r) o[db][qb][r] = 0.f;
    float mrun[2] = {-1e30f, -1e30f}, lrun[2] = {0.f, 0.f};
    const int j0 = (nchunk < 8) ? (8 - nchunk) : 0;
    const int t0 = 2 * j0;
    const int ntl = 18 - t0;
#define TILE_OF(idx) ((nchunk >= 8) ? 2 * ((((idx) >> 1) + 80 - nchunk) % 9) + ((idx) & 1) : t0 + (idx))
#define KTOK(t) ((size_t)b * SEQ + (size_t)(nchunk - 8 + ((t) >> 1)) * 64 + 32 * ((t) & 1))
    bf16x8 kf[4]; u32x4 vch[4];
    { const size_t kt = KTOK(TILE_OF(0));
#pragma unroll
        for (int ds = 0; ds < 4; ++ds) kf[ds] = *(const bf16x8*)(PROJ + (kt + q32) * NIN + C_K + h * 64 + 16 * ds + 8 * hi);
#pragma unroll
        for (int i = 0; i < 4; ++i) { const int cc = lane + 64 * i, key = cc >> 3, c8 = cc & 7; vch[i] = *(const u32x4*)(PROJ + (kt + key) * NIN + C_V + h * 64 + 8 * c8); }
#pragma unroll
        for (int i = 0; i < 4; ++i) { const int cc = lane + 64 * i, key = cc >> 3, c8 = cc & 7; *(LAS u32x4*)(wl + 0 * 4096 + (c8 >> 2) * 2048 + key * 64 + (c8 & 3) * 16) = vch[i]; }
    }
    const int gI = lane >> 4, li = lane & 15, qrow = li >> 2, pp = li & 3;
    const int vtr_off = (4 * hi + qrow) * 64 + (16 * (gI & 1) + 4 * pp) * 2;
    for (int idx = 0; idx < ntl; ++idx) {
        const int t = TILE_OF(idx);
        bf16x8 kfn[4];
        const bool more = (idx + 1 < ntl);
        if (more) { const size_t kt = KTOK(TILE_OF(idx + 1));
#pragma unroll
            for (int ds = 0; ds < 4; ++ds) kfn[ds] = *(const bf16x8*)(PROJ + (kt + q32) * NIN + C_K + h * 64 + 16 * ds + 8 * hi);
#pragma unroll
            for (int i = 0; i < 4; ++i) { const int cc = lane + 64 * i, key = cc >> 3, c8 = cc & 7; vch[i] = *(const u32x4*)(PROJ + (kt + key) * NIN + C_V + h * 64 + 8 * c8); }
        } else {
#pragma unroll
            for (int ds = 0; ds < 4; ++ds) kfn[ds] = kf[ds];
        }
        const int j = t >> 1, kb = t & 1;
        f32x16 s[2];
        if (j >= 6) {
#pragma unroll
            for (int qb = 0; qb < 2; ++qb) { const int base = 32 * qb + q32 - 32 * kb - 4 * hi + 64 * (8 - j) + 63;
#pragma unroll
                for (int r = 0; r < 16; ++r) s[qb][r] = T[base - ((r & 3) + 8 * (r >> 2))]; }
        } else {
#pragma unroll
            for (int qb = 0; qb < 2; ++qb)
#pragma unroll
                for (int r = 0; r < 16; ++r) s[qb][r] = 0.f;
        }
#pragma unroll
        for (int ds = 0; ds < 4; ++ds)
#pragma unroll
            for (int qb = 0; qb < 2; ++qb) s[qb] = __builtin_amdgcn_mfma_f32_32x32x16_bf16(kf[ds], qf[qb][ds], s[qb], 0, 0, 0);
        bf16x8 pf[2][2];
#pragma unroll
        for (int qb = 0; qb < 2; ++qb) {
            float mx = s[qb][0];
#pragma unroll
            for (int r = 1; r < 16; ++r) mx = fmaxf(mx, s[qb][r]);
            mx = fmaxf(mx, __shfl_xor(mx, 32));
            const float mnew = fmaxf(mrun[qb], mx);
            const float alpha = __builtin_amdgcn_exp2f(mrun[qb] - mnew);
            mrun[qb] = mnew;
            float ls = 0.f;
#pragma unroll
            for (int r = 0; r < 16; ++r) { const float p = __builtin_amdgcn_exp2f(s[qb][r] - mnew); s[qb][r] = p; ls += p; }
            lrun[qb] = lrun[qb] * alpha + ls;
#pragma unroll
            for (int db = 0; db < 2; ++db)
#pragma unroll
                for (int r = 0; r < 16; ++r) o[db][qb][r] *= alpha;
#pragma unroll
            for (int s2 = 0; s2 < 2; ++s2) { u32x4 w; w.x = cvtpk(s[qb][8 * s2 + 0], s[qb][8 * s2 + 1]); w.y = cvtpk(s[qb][8 * s2 + 2], s[qb][8 * s2 + 3]);
                w.z = cvtpk(s[qb][8 * s2 + 4], s[qb][8 * s2 + 5]); w.w = cvtpk(s[qb][8 * s2 + 6], s[qb][8 * s2 + 7]); pf[qb][s2] = __builtin_bit_cast(bf16x8, w); }
        }
        asm volatile("s_waitcnt lgkmcnt(0)" ::: "memory");
        { LAS unsigned char* vb = wl + (idx & 1) * 4096 + vtr_off;
#pragma unroll
            for (int db = 0; db < 2; ++db)
#pragma unroll
                for (int s2 = 0; s2 < 2; ++s2) {
                    const s16x4 lo = __builtin_bit_cast(s16x4, __builtin_amdgcn_ds_read_tr16_b64_v4i16((LAS s16x4*)(vb + db * 2048 + (16 * s2) * 64)));
                    const s16x4 hh = __builtin_bit_cast(s16x4, __builtin_amdgcn_ds_read_tr16_b64_v4i16((LAS s16x4*)(vb + db * 2048 + (16 * s2 + 8) * 64)));
                    const bf16x8 vf = {lo[0], lo[1], lo[2], lo[3], hh[0], hh[1], hh[2], hh[3]};
#pragma unroll
                    for (int qb = 0; qb < 2; ++qb) o[db][qb] = __builtin_amdgcn_mfma_f32_32x32x16_bf16(vf, pf[qb][s2], o[db][qb], 0, 0, 0);
                } }
        asm volatile("s_waitcnt lgkmcnt(0)" ::: "memory");
        if (more) {
#pragma unroll
            for (int i = 0; i < 4; ++i) { const int cc = lane + 64 * i, key = cc >> 3, c8 = cc & 7; *(LAS u32x4*)(wl + ((idx + 1) & 1) * 4096 + (c8 >> 2) * 2048 + key * 64 + (c8 & 3) * 16) = vch[i]; }
        }
#pragma unroll
        for (int ds = 0; ds < 4; ++ds) kf[ds] = kfn[ds];
    }
#undef KTOK
#undef TILE_OF
    {
        u32x4 zq[2][2][2];
#pragma unroll
        for (int qb = 0; qb < 2; ++qb)
#pragma unroll
            for (int db = 0; db < 2; ++db)
#pragma unroll
                for (int k = 0; k < 2; ++k) zq[qb][db][k] = *(const u32x4*)(PROJ + (tok0 + 32 * qb + q32) * NIN + h * 64 + C_ZA + 32 * db + 16 * k + 8 * hi);
#pragma unroll
        for (int qb = 0; qb < 2; ++qb) {
            const float lt = lrun[qb] + __shfl_xor(lrun[qb], 32);
            const float inv = 1.0f / lt;
            bf16_t* rowp = PROJ + (tok0 + 32 * qb + q32) * NIN + h * 64;
#pragma unroll
            for (int db = 0; db < 2; ++db)
#pragma unroll
                for (int k = 0; k < 2; ++k) {
                    const u32x4 z = zq[qb][db][k];
                    const auto s0 = __builtin_amdgcn_permlane32_swap(z.x, z.z, false, false), s1 = __builtin_amdgcn_permlane32_swap(z.y, z.w, false, false);
                    const unsigned ax = s0[0], bx = s0[1], ay = s1[0], by = s1[1];
                    const unsigned wax = cvtpk(o[db][qb][8 * k + 0] * inv * bflo(ax), o[db][qb][8 * k + 1] * inv * bfhi(ax));
                    const unsigned way = cvtpk(o[db][qb][8 * k + 2] * inv * bflo(ay), o[db][qb][8 * k + 3] * inv * bfhi(ay));
                    const unsigned wbx = cvtpk(o[db][qb][8 * k + 4] * inv * bflo(bx), o[db][qb][8 * k + 5] * inv * bfhi(bx));
                    const unsigned wby = cvtpk(o[db][qb][8 * k + 6] * inv * bflo(by), o[db][qb][8 * k + 7] * inv * bfhi(by));
                    const auto t0 = __builtin_amdgcn_permlane32_swap(wax, wbx, false, false), t1 = __builtin_amdgcn_permlane32_swap(way, wby, false, false);
                    u32x4 w; w.x = t0[0]; w.y = t1[0]; w.z = t0[1]; w.w = t1[1];
                    *(u32x4*)(rowp + C_Q + 32 * db + 16 * k + 8 * hi) = w; }
        }
    }
    asm volatile("s_waitcnt lgkmcnt(0)" ::: "memory");
}

#define XB_TMO      128
#define XB_XCNT(j)  (256  + 64 * (j))
#define XB_XSUB(j)  (1280 + 64 * (j))
#define XB_XGEN(j)  (2304 + 64 * (j))
#define XB_TOP      3328
#define XB_TOPGEN   3392
#define XCD_BAR_WORDS 3456
#define XB_SPIN_CAP (1u << 20)
__device__ __forceinline__ unsigned xb_ld(unsigned* p)              { return __hip_atomic_load(p, __ATOMIC_RELAXED, __HIP_MEMORY_SCOPE_AGENT); }
__device__ __forceinline__ unsigned xb_add(unsigned* p, unsigned v) { return __hip_atomic_fetch_add(p, v, __ATOMIC_RELAXED, __HIP_MEMORY_SCOPE_AGENT); }
__device__ __forceinline__ unsigned xb_xcc_id() { return (unsigned)__builtin_amdgcn_s_getreg((3 << 11) | 20) & 0xFu; }
#define XB_SPIN(cond, bar) do { unsigned _sp = 0; while (cond) { __builtin_amdgcn_s_sleep(1); \
    if ((++_sp & 255u) == 0u) { if (xb_ld(&(bar)[XB_TMO])) break; if (_sp > XB_SPIN_CAP) { atomicAdd(&(bar)[XB_TMO], 1u); break; } } } } while (0)
struct XcdBarrier { unsigned* bar; unsigned x; volatile LAS unsigned* st; };
__device__ __forceinline__ XcdBarrier xcd_barrier_post(unsigned* bar, volatile LAS unsigned* st) {
    XcdBarrier b; b.bar = bar; b.x = xb_xcc_id(); b.st = st;
    if (threadIdx.x == 0) (void)xb_add(&bar[XB_XCNT(b.x)], 1u);
    return b;
}
__device__ __forceinline__ void xcd_barrier_complete(unsigned* bar, unsigned x, unsigned& nloc, unsigned& nx) {
    const unsigned G = gridDim.x * gridDim.y * gridDim.z;
    unsigned sum, cnt, mine, sp = 0u;
    for (;;) {
        sum = 0u; cnt = 0u; mine = 0u;
#pragma unroll
        for (unsigned j = 0; j < 16; ++j) { const unsigned c = xb_ld(&bar[XB_XCNT(j)]); sum += c; cnt += (c > 0u) ? 1u : 0u; mine = (j == x) ? c : mine; }
        if (sum == G) break;
        __builtin_amdgcn_s_sleep(1);
        if ((++sp & 255u) == 0u) { if (xb_ld(&bar[XB_TMO])) break; if (sp > XB_SPIN_CAP) { atomicAdd(&bar[XB_TMO], 1u); break; } }
    }
    nloc = mine > 0u ? mine : 1u; nx = cnt > 0u ? cnt : 1u;
}
__device__ __forceinline__ void xcd_barrier(const XcdBarrier& b) {
    asm volatile("s_waitcnt vmcnt(0)" ::: "memory");
    __syncthreads();
    if (threadIdx.x == 0) {
        unsigned* bar = b.bar;
        __builtin_amdgcn_s_waitcnt(0);
        unsigned nloc = b.st[0], nx = b.st[1];
        if (nloc == 0u) { xcd_barrier_complete(bar, b.x, nloc, nx); b.st[0] = nloc; b.st[1] = nx; }
        const unsigned old = xb_add(&bar[XB_XSUB(b.x)], 1u);
        const unsigned gen = old / nloc;
        if (old + 1u == (gen + 1u) * nloc) {
            __builtin_amdgcn_fence(__ATOMIC_RELEASE, "agent");
            asm volatile("s_waitcnt vmcnt(0)" ::: "memory");
            const unsigned og = xb_add(&bar[XB_TOP], 1u);
            const unsigned tg = og / nx;
            if (og + 1u == (tg + 1u) * nx) xb_add(&bar[XB_TOPGEN], 1u);
            else XB_SPIN(xb_ld(&bar[XB_TOPGEN]) == tg, bar);
            __builtin_amdgcn_fence(__ATOMIC_ACQUIRE, "agent");
            xb_add(&bar[XB_XGEN(b.x)], 1u);
            asm volatile("s_waitcnt vmcnt(0)" ::: "memory");
        } else {
            XB_SPIN(xb_ld(&bar[XB_XGEN(b.x)]) == gen, bar);
            __builtin_amdgcn_fence(__ATOMIC_ACQUIRE, "agent");
            asm volatile("s_waitcnt vmcnt(0)" ::: "memory");
        }
    }
    __syncthreads();
}

__device__ __forceinline__ void group_sync(unsigned* cnt, int wave) {
    asm volatile("s_waitcnt vmcnt(0)" ::: "memory");
    __syncthreads();
    if (wave == 0) {
        if (__lane_id() == 0) __hip_atomic_fetch_add(cnt, 1u, __ATOMIC_RELAXED, __HIP_MEMORY_SCOPE_AGENT);
        unsigned sp = 0;
        while ((unsigned)__builtin_amdgcn_readfirstlane(__hip_atomic_load(cnt, __ATOMIC_RELAXED, __HIP_MEMORY_SCOPE_AGENT)) < 4u) { __builtin_amdgcn_s_sleep(2); if (++sp > (1u << 22)) break; }
        __builtin_amdgcn_fence(__ATOMIC_ACQUIRE, "agent");
    }
    asm volatile("s_waitcnt vmcnt(0) lgkmcnt(0)" ::: "memory");
    __syncthreads();
}

struct Args {
    const float* in[19]; float* out; unsigned char* ws; int use_cg; int pad;
};

__global__ void __launch_bounds__(NWAVES * 64, 2) fwd_megakernel(Args a) {
    extern __shared__ __attribute__((aligned(16))) unsigned char lds_raw[];
    LAS unsigned char* lds = (LAS unsigned char*)lds_raw;
    cg::grid_group grid = cg::this_grid();
    const int tid = threadIdx.x, lane = tid & 63, wave = __builtin_amdgcn_readfirstlane(tid >> 6);
    const int G = gridDim.x, bx = blockIdx.x;
    if (tid < 2) ((volatile LAS unsigned*)(lds + MISC_OFF))[tid] = 0u;
    __syncthreads();
    const XcdBarrier xbar = xcd_barrier_post((unsigned*)(a.ws + WS_CTL), (volatile LAS unsigned*)(lds + MISC_OFF));
#define TS(i) do { if (PROBE_A >= 0 && bx == 0 && tid == 0) ((volatile LAS unsigned long long*)(lds + MISC_OFF + 64))[i] = __builtin_amdgcn_s_memrealtime(); } while (0)
    TS(0);
#define GRID_SEAM() do { if (a.use_cg) grid.sync(); else xcd_barrier(xbar); } while (0)
    const int vcu = (G % 8 == 0) ? (bx % 8) * (G / 8) + bx / 8 : bx;
    unsigned char* ws = a.ws;
    const float* x = a.in[0];
    bf16_t* WinT = (bf16_t*)(ws + WS_WIN); bf16_t* WgluT = (bf16_t*)(ws + WS_WGLU); bf16_t* WaoT = (bf16_t*)(ws + WS_WAO);
    bf16_t* WsoT = (bf16_t*)(ws + WS_WSO); bf16_t* WoutT = (bf16_t*)(ws + WS_WOUT);
    float* SSQ = (float*)(ws + WS_SSQ);
    bf16_t* XN = (bf16_t*)(ws + WS_XN);
    bf16_t* PROJ = (bf16_t*)(ws + WS_PROJ);

    {
        LAS float* scr = (LAS float*)(lds + wave * 16384);
        const int gw = bx * NWAVES + wave, NGW = G * NWAVES;
        constexpr int I_IN = (DM / 64) * (NIN / 32), I_GLU = (512 / 64) * (1024 / 32), I_AO = I_GLU, I_SO = I_GLU, I_OUT = (DM / 64) * (DM / 32);
        constexpr int NITEMS = I_IN + I_GLU + I_AO + I_SO + I_OUT;
        for (int it = gw; it < NITEMS; it += NGW) {
            int r = it;
            if (r < I_IN) { p0_transpose_item(a.in[2], DM, NIN, WinT, 2, scr, r, lane); continue; } r -= I_IN;
            if (r < I_GLU) { p0_transpose_item(a.in[12], 512, 1024, WgluT, 1, scr, r, lane); continue; } r -= I_GLU;
            if (r < I_AO) { p0_transpose_item(a.in[14], 512, 1024, WaoT, 0, scr, r, lane); continue; } r -= I_AO;
            if (r < I_SO) { p0_transpose_item(a.in[15], 512, 1024, WsoT, 0, scr, r, lane); continue; } r -= I_SO;
            p0_transpose_item(a.in[17], DM, DM, WoutT, 0, scr, r, lane);
        }
        const float* gain = a.in[1];
        f32x4 gv[4];
#pragma unroll
        for (int j = 0; j < 4; ++j) gv[j] = *(const f32x4*)(gain + 4 * lane + 256 * j);
        for (int m = gw; m < M_TOK; m += 2 * NGW) {
            const int m1 = m + NGW; const bool two = m1 < M_TOK;
            const f32x4* xr0 = (const f32x4*)(x + (size_t)m * DM) + lane; const f32x4* xr1 = (const f32x4*)(x + (size_t)(two ? m1 : m) * DM) + lane;
            f32x4 v[4], w4[4]; float s = 0.f, s1 = 0.f;
#pragma unroll
            for (int j = 0; j < 4; ++j) { v[j] = __builtin_nontemporal_load(&xr0[64 * j]); w4[j] = __builtin_nontemporal_load(&xr1[64 * j]); }
#pragma unroll
            for (int j = 0; j < 4; ++j) { s += (v[j][0] * v[j][0] + v[j][1] * v[j][1]) + (v[j][2] * v[j][2] + v[j][3] * v[j][3]); s1 += (w4[j][0] * w4[j][0] + w4[j][1] * w4[j][1]) + (w4[j][2] * w4[j][2] + w4[j][3] * w4[j][3]); }
            const float inv = 1.0f / sqrtf(wave_sum(s) * (1.f / DM) + NORM_EPS), inv1 = 1.0f / sqrtf(wave_sum(s1) * (1.f / DM) + NORM_EPS);
            u32x2* o8 = (u32x2*)(XN + (size_t)m * DM) + lane;
#pragma unroll
            for (int j = 0; j < 4; ++j) { u32x2 w; w.x = cvtpk(v[j][0] * inv * gv[j][0], v[j][1] * inv * gv[j][1]); w.y = cvtpk(v[j][2] * inv * gv[j][2], v[j][3] * inv * gv[j][3]); o8[64 * j] = w; }
            if (two) { u32x2* o9 = (u32x2*)(XN + (size_t)m1 * DM) + lane;
#pragma unroll
                for (int j = 0; j < 4; ++j) { u32x2 w; w.x = cvtpk(w4[j][0] * inv1 * gv[j][0], w4[j][1] * inv1 * gv[j][1]); w.y = cvtpk(w4[j][2] * inv1 * gv[j][2], w4[j][3] * inv1 * gv[j][3]); o9[64 * j] = w; } }
        }
    }
    GRID_SEAM(); TS(1);

    {
        pg8::Gemm g{XN, XN, WinT, WinT, DM, DM}; pg8::StaticOrder S; S.init(M_TOK, NIN, G, bx, 1);
        pg8::EpiProj E{PROJ, a.in[16]};
        pg8::gemm_phase<pg8::EpiProj>(lds, g, S, E);
    }
    GRID_SEAM(); TS(2);

    {
        SsmIn si{a.in[4], a.in[5], a.in[6], a.in[7], a.in[8], a.in[9], a.in[10], a.in[11]};
        for (int sidx = vcu; sidx < NBATCH * 32; sidx += G) ssm_unit(sidx >> 5, sidx & 31, PROJ, si, lds, wave, lane);
        TS(8);
        LAS unsigned char* wl = lds + wave * ATT_WAVE_LDS;
        attn_build_table(a.in[3], wave, wl, lane);
        const int NU = NBATCH * 64, per = (NU + G - 1) / G;
        for (int i = 0; i < per; ++i) { const int uidx = vcu * per + i; if (uidx < NU) attn_unit(uidx >> 6, uidx & 63, wave, PROJ, wl, lane); }
    }
    GRID_SEAM(); TS(3);

    {
        pg8::Gemm g{PROJ + C_U, PROJ + C_U, WgluT, WgluT, NIN, 512}; pg8::StaticOrder S; S.init(M_TOK, 1024, G, bx, 1);
        pg8::EpiGlu E{PROJ, a.in[13]};
        pg8::gemm_phase<pg8::EpiGlu>(lds, g, S, E);
    }
    if (G == 256) group_sync((unsigned*)(a.ws + WS_CTL + CTL_G3_OFF) + 64 * (bx & 63), wave); else GRID_SEAM();
    TS(4);

    {
        pg8::Gemm g{PROJ + C_Q, PROJ + C_ZS, WaoT, WsoT, NIN, 512}; pg8::StaticOrder S; S.init(M_TOK, DM, G, bx, 2);
        pg8::EpiMerge E{PROJ, XN};
        pg8::gemm_phase<pg8::EpiMerge>(lds, g, S, E);
    }
    if (G == 256) group_sync((unsigned*)(a.ws + WS_CTL + CTL_G4_OFF) + 64 * (bx & 63), wave); else GRID_SEAM();
    TS(5);

    {
        pg8::Gemm g{XN, XN, WoutT, WoutT, DM, DM}; pg8::StaticOrder S; S.init(M_TOK, DM, G, bx, 1);
        pg8::EpiOutNorm E{x, a.out, a.in[18], SSQ, (unsigned*)(a.ws + WS_CTL + CTL_CNT_OFF), lds};
        pg8::gemm_phase<pg8::EpiOutNorm>(lds, g, S, E);
    }
    TS(6);
    if (PROBE_A >= 0 && bx == 0 && tid == 0) {
        TS(7);
        volatile LAS unsigned long long* ts = (volatile LAS unsigned long long*)(lds + MISC_OFF + 64);
        const int ia0 = (PROBE_A == 8) ? 2 : PROBE_A, ia1 = (PROBE_A == 8) ? 8 : PROBE_A + 1, ib0 = (PROBE_B == 8) ? 2 : (PROBE_B == 10) ? 3 : PROBE_B, ib1 = (PROBE_B == 8) ? 8 : (PROBE_B == 10) ? 6 : PROBE_B + 1;
        const unsigned long long tA = (PROBE_A == 9) ? 0ull : ts[ia1] - ts[ia0], tB = ts[ib1] - ts[ib0];
        const unsigned long long X = 100000ull * ((tA + 250ull) / 500ull) + 2ull * tB;
        const unsigned long long t0 = __builtin_amdgcn_s_memrealtime();
        while (__builtin_amdgcn_s_memrealtime() - t0 < X) __builtin_amdgcn_s_sleep(8);
    }
}

extern "C" void kernel_launch(void* const* d_in, const int* in_sizes, int n_in, void* d_out, int out_size, void* d_ws, size_t ws_size, hipStream_t stream) {
    static int grid = 0;
    if (grid == 0) {
        if (n_in != 19 || in_sizes[0] != M_TOK * DM || out_size != M_TOK * DM || ws_size < WS_END) { fprintf(stderr, "kernel_launch: unexpected shapes (n_in %d, ws %zu)\n", n_in, ws_size); grid = -1; return; }
        int dev = 0, cus = 0, per_cu = 0;
        hipGetDevice(&dev);
        hipDeviceGetAttribute(&cus, hipDeviceAttributeMultiprocessorCount, dev);
        hipFuncSetAttribute((const void*)fwd_megakernel, hipFuncAttributeMaxDynamicSharedMemorySize, LDS_BYTES);
        hipOccupancyMaxActiveBlocksPerMultiprocessor(&per_cu, (const void*)fwd_megakernel, NWAVES * 64, LDS_BYTES);
        if (per_cu < 1) per_cu = 1;
        grid = cus * per_cu;
        (void)hipGetLastError();
    }
    if (grid < 0) return;
    Args a{};
    for (int i = 0; i < 19; ++i) a.in[i] = (const float*)d_in[i];
    a.out = (float*)d_out; a.ws = (unsigned char*)d_ws; a.use_cg = 0; a.pad = 0;
    if (hipMemsetAsync((char*)d_ws + WS_CTL, 0, CTL_ZERO_BYTES, stream) != hipSuccess) { fprintf(stderr, "kernel_launch: memset failed\n"); return; }
    void* args[] = {&a};
    hipError_t e = hipLaunchCooperativeKernel((const void*)fwd_megakernel, dim3(grid), dim3(NWAVES * 64), args, LDS_BYTES, stream);
    if (e != hipSuccess) fprintf(stderr, "cooperative launch failed: %s (grid %d)\n", hipGetErrorString(e), grid);
}
```
